# Optimizing an MI355X kernel written in HIP

```python
import jax, jax.numpy as jnp
from jax import lax
import numpy as np

D_MODEL = 1024
BATCH = 8
SEQ = 4096
DEPTH = 1

N_META = 16
NORM_EPS = 1e-5
GLA_HEADS = 4
GLA_KEY = D_MODEL // 2
GLA_VAL = D_MODEL
GLA_DK = GLA_KEY // GLA_HEADS
GLA_DV = GLA_VAL // GLA_HEADS
GLA_GATE_RANK = 16
GLA_GATE_NORM = 16.0
GLA_CHUNK = 64
RWKV_HEAD = 64
RWKV_WIDTH = D_MODEL
RWKV_HEADS = RWKV_WIDTH // RWKV_HEAD
RWKV_DECAY_RANK = 64
RWKV_A_RANK = 64
RWKV_GATE_RANK = 160
RWKV_GN_EPS = 64e-5
N_EXPERTS = 32
TOP_K = 4
D_EXPERT = D_MODEL
SWIGLU_LIMIT = 7.0
SWIGLU_ALPHA = 1.702
IN_SPLITS = (GLA_KEY, GLA_KEY, GLA_VAL, GLA_VAL, GLA_GATE_RANK,
             RWKV_WIDTH, RWKV_WIDTH, RWKV_WIDTH, RWKV_DECAY_RANK, RWKV_A_RANK, RWKV_GATE_RANK,
             D_MODEL, D_MODEL)
D_IN = sum(IN_SPLITS)

kernel_name = 'hybrid_gla_rwkv7_moe_block'


def rmsnorm(x, g):
    xf = x.astype(jnp.float32)
    y = xf * lax.rsqrt(jnp.mean(xf * xf, axis=-1, keepdims=True) + NORM_EPS)
    return (y * g).astype(x.dtype)


def token_shift(z):
    return jnp.pad(z, ((0, 0), (1, 0), (0, 0)))[:, :-1]


def gla_branch(q, k, v, r, a_low, w_gla_a2, b_gla_a, gla_norm_g):
    B, L, _ = q.shape
    f32 = jnp.float32
    C = GLA_CHUNK
    pad = (-N_META) % C
    gk = jax.nn.log_sigmoid((a_low @ w_gla_a2 + b_gla_a).astype(f32)) / GLA_GATE_NORM

    def chunks(z, dh):
        z = jnp.pad(z.astype(f32), ((0, 0), (pad, 0), (0, 0)))
        return z.reshape(B, -1, C, GLA_HEADS, dh).transpose(0, 3, 1, 2, 4)

    qc = chunks(q, GLA_DK) * GLA_DK ** -0.5
    kc = chunks(k, GLA_DK)
    vc = chunks(v, GLA_DV)
    b = jnp.cumsum(chunks(gk, GLA_DK), axis=3)
    b_ref = b[:, :, :, C // 2 - 1:C // 2]
    A = jnp.einsum('bhnid,bhnjd->bhnij', qc * jnp.exp(b - b_ref), kc * jnp.exp(b_ref - b))
    A = jnp.where(jnp.tril(jnp.ones((C, C), dtype=bool)), A, 0.0)
    o_intra = jnp.einsum('bhnij,bhnjv->bhniv', A, vc)
    b_last = b[:, :, :, -1:]
    chunk_kv = jnp.einsum('bhncd,bhncv->bhndv', kc * jnp.exp(b_last - b), vc)
    chunk_decay = jnp.exp(b_last[:, :, :, 0])

    def step(S, inp):
        d, kv = inp
        return d[..., None] * S + kv, S

    S0 = jnp.zeros((B, GLA_HEADS, GLA_DK, GLA_DV), f32)
    _, S_start = lax.scan(step, S0, (jnp.moveaxis(chunk_decay, 2, 0), jnp.moveaxis(chunk_kv, 2, 0)))
    S_start = jnp.moveaxis(S_start, 0, 2)
    o_inter = jnp.einsum('bhncd,bhndv->bhncv', qc * jnp.exp(b), S_start)
    o = (o_intra + o_inter).transpose(0, 2, 3, 1, 4).reshape(B, -1, GLA_HEADS, GLA_DV)[:, pad:]
    o = o * lax.rsqrt(jnp.mean(o * o, axis=-1, keepdims=True) + NORM_EPS) * gla_norm_g
    o = o.reshape(B, L, GLA_VAL) * jax.nn.silu(r.astype(f32))
    return o.astype(q.dtype)


def rwkv7_branch(pr, pk, pv, pw, pa, pg, mu_r, mu_k, mu_v, mu_w, mu_a, mu_g,
                 w_decay2, b_decay, w_a2, b_a, w_gate2, k_k, k_a, r_k, ln_x_g, ln_x_b):
    B, L, _ = pr.shape
    f32 = jnp.float32
    lerp = lambda z, mu: (z + (token_shift(z) - z) * mu).astype(f32)
    r = lerp(pr, mu_r)
    k = lerp(pk, mu_k)
    v = lerp(pv, mu_v)
    w_log = -jax.nn.softplus(-(b_decay + jnp.tanh(lerp(pw, mu_w)) @ w_decay2)) - 0.5
    decay = jnp.exp(-jnp.exp(w_log))
    a = jax.nn.sigmoid(b_a + lerp(pa, mu_a) @ w_a2)
    g = jax.nn.sigmoid(lerp(pg, mu_g)) @ w_gate2
    heads = lambda z: z.reshape(B, L, RWKV_HEADS, RWKV_HEAD)
    r, k, v, decay, a = heads(r), heads(k), heads(v), heads(decay), heads(a)
    kk = k * k_k.reshape(RWKV_HEADS, RWKV_HEAD)
    kk = kk / jnp.maximum(jnp.sqrt(jnp.sum(kk * kk, axis=-1, keepdims=True)), 1e-12)
    k = k * (1.0 + (a - 1.0) * k_a.reshape(RWKV_HEADS, RWKV_HEAD))

    def step(S, inp):
        r_t, w_t, k_t, v_t, a_t, b_t = inp
        sa = jnp.einsum('bhij,bhj->bhi', S, a_t)
        S = S * w_t[:, :, None, :] + sa[..., None] * b_t[:, :, None, :] + v_t[..., None] * k_t[:, :, None, :]
        return S, jnp.einsum('bhij,bhj->bhi', S, r_t)

    tm = lambda z: jnp.moveaxis(z, 1, 0)
    S0 = jnp.zeros((B, RWKV_HEADS, RWKV_HEAD, RWKV_HEAD), f32)
    _, ys = lax.scan(step, S0, (tm(r), tm(decay), tm(k), tm(v), tm(-kk), tm(kk * a)))
    y = jnp.moveaxis(ys, 0, 1)
    mean = jnp.mean(y, axis=-1, keepdims=True)
    var = jnp.mean(jnp.square(y - mean), axis=-1, keepdims=True)
    y = (y - mean) * lax.rsqrt(var + RWKV_GN_EPS)
    y = y * ln_x_g.reshape(RWKV_HEADS, RWKV_HEAD) + ln_x_b.reshape(RWKV_HEADS, RWKV_HEAD)
    y = y + jnp.sum(r * k * r_k, axis=-1, keepdims=True) * v
    return (y.reshape(B, L, RWKV_WIDTH) * g).astype(pr.dtype)


def moe_ffn(u, w_router, b_router, w_exp_gu, b_exp_gu, w_exp_down, b_exp_down):
    B, L, D = u.shape
    ut = u.reshape(B * L, D)
    logits = (ut @ w_router + b_router).astype(jnp.float32)
    top_vals, top_idx = lax.top_k(logits, TOP_K)
    probs = jax.nn.softmax(top_vals, axis=-1)
    comb = jnp.sum(jax.nn.one_hot(top_idx, N_EXPERTS, dtype=jnp.float32) * probs[..., None], axis=1)
    comb = comb.astype(ut.dtype)

    def expert(acc, p):
        w_gu, b_gu, w_dn, b_dn, c_e = p
        h = ut @ w_gu + b_gu
        gate, up = h[:, :D_EXPERT], h[:, D_EXPERT:]
        gate = jnp.minimum(gate, SWIGLU_LIMIT)
        up = jnp.clip(up, -SWIGLU_LIMIT, SWIGLU_LIMIT)
        out = ((up + 1.0) * (gate * jax.nn.sigmoid(gate * SWIGLU_ALPHA))) @ w_dn + b_dn
        return acc + c_e[:, None] * out, None

    acc, _ = lax.scan(expert, jnp.zeros_like(ut), (w_exp_gu, b_exp_gu, w_exp_down, b_exp_down, comb.T))
    return acc.reshape(B, L, D)


def setup_inputs(seed: int = 0) -> dict:
    key = jax.random.key(seed)
    ks = list(jax.random.split(key, 48))
    it = iter(ks)
    D, Ly = D_MODEL, DEPTH
    nrm = lambda shape, s: jax.random.normal(next(it), shape, jnp.float32) * s
    uni = lambda shape, lo, hi: jax.random.uniform(next(it), shape, jnp.float32, lo, hi)
    gain = lambda shape: 1.0 + nrm(shape, 0.02)
    return {
        'x': nrm((BATCH, SEQ, D), 1.0),
        'meta_tokens': nrm((N_META, D), 1.0),
        'norm_mix_g': gain((Ly, D)),
        'w_in': nrm((Ly, D, D_IN), D ** -0.5),
        'w_gla_a2': nrm((Ly, GLA_GATE_RANK, GLA_KEY), GLA_GATE_RANK ** -0.5),
        'b_gla_a': nrm((Ly, GLA_KEY), 1.0),
        'gla_norm_g': gain((Ly, GLA_DV)),
        'w_gla_o': nrm((Ly, GLA_VAL, D), GLA_VAL ** -0.5),
        'mu_r': uni((Ly, RWKV_WIDTH), 0.0, 1.0),
        'mu_k': uni((Ly, RWKV_WIDTH), 0.0, 1.0),
        'mu_v': uni((Ly, RWKV_WIDTH), 0.0, 1.0),
        'mu_w': uni((Ly, RWKV_DECAY_RANK), 0.0, 1.0),
        'mu_a': uni((Ly, RWKV_A_RANK), 0.0, 1.0),
        'mu_g': uni((Ly, RWKV_GATE_RANK), 0.0, 1.0),
        'w_decay2': nrm((Ly, RWKV_DECAY_RANK, RWKV_WIDTH), RWKV_DECAY_RANK ** -0.5),
        'b_decay': uni((Ly, RWKV_WIDTH), -5.0, 1.0),
        'w_a2': nrm((Ly, RWKV_A_RANK, RWKV_WIDTH), RWKV_A_RANK ** -0.5),
        'b_a': nrm((Ly, RWKV_WIDTH), 0.1),
        'w_gate2': nrm((Ly, RWKV_GATE_RANK, RWKV_WIDTH), RWKV_GATE_RANK ** -0.5),
        'k_k': 0.85 + nrm((Ly, RWKV_WIDTH), 0.02),
        'k_a': gain((Ly, RWKV_WIDTH)),
        'r_k': nrm((Ly, RWKV_HEADS, RWKV_HEAD), 0.1),
        'ln_x_g': gain((Ly, RWKV_WIDTH)),
        'ln_x_b': nrm((Ly, RWKV_WIDTH), 0.01),
        'w_rwkv_o': nrm((Ly, RWKV_WIDTH, D), RWKV_WIDTH ** -0.5),
        'w_out': nrm((Ly, D, D), D ** -0.5),
        'norm_ffn_g': gain((Ly, D)),
        'w_router': nrm((Ly, D, N_EXPERTS), D ** -0.5),
        'b_router': nrm((Ly, N_EXPERTS), 0.01),
        'w_exp_gu': nrm((Ly, N_EXPERTS, D, 2 * D_EXPERT), D ** -0.5),
        'b_exp_gu': nrm((Ly, N_EXPERTS, 2 * D_EXPERT), 0.01),
        'w_exp_down': nrm((Ly, N_EXPERTS, D_EXPERT, D), D_EXPERT ** -0.5),
        'b_exp_down': nrm((Ly, N_EXPERTS, D), 0.01),
        'norm_final_g': gain((D,)),
    }


def reference(x, meta_tokens, norm_mix_g, w_in, w_gla_a2, b_gla_a, gla_norm_g, w_gla_o,
              mu_r, mu_k, mu_v, mu_w, mu_a, mu_g, w_decay2, b_decay, w_a2, b_a, w_gate2,
              k_k, k_a, r_k, ln_x_g, ln_x_b, w_rwkv_o, w_out, norm_ffn_g,
              w_router, b_router, w_exp_gu, b_exp_gu, w_exp_down, b_exp_down, norm_final_g):
    B = x.shape[0]
    meta = jnp.broadcast_to(meta_tokens[None].astype(x.dtype), (B, N_META, D_MODEL))
    h = jnp.concatenate([meta, x], axis=1)
    offsets = [int(o) for o in np.cumsum(IN_SPLITS)[:-1]]
    for l in range(DEPTH):
        u = rmsnorm(h, norm_mix_g[l])
        P = u @ w_in[l]
        (gq, gk_, gv, gr, ga, rr, rk, rv, rw, ra, rg, gate_gla, gate_rwkv) = jnp.split(P, offsets, axis=-1)
        o_gla = gla_branch(gq, gk_, gv, gr, ga, w_gla_a2[l], b_gla_a[l], gla_norm_g[l]) @ w_gla_o[l]
        o_rwkv = rwkv7_branch(rr, rk, rv, rw, ra, rg, mu_r[l], mu_k[l], mu_v[l], mu_w[l], mu_a[l], mu_g[l],
                              w_decay2[l], b_decay[l], w_a2[l], b_a[l], w_gate2[l], k_k[l], k_a[l], r_k[l],
                              ln_x_g[l], ln_x_b[l]) @ w_rwkv_o[l]
        mix = jax.nn.sigmoid(gate_gla) * o_gla + jax.nn.sigmoid(gate_rwkv) * o_rwkv
        h = h + mix @ w_out[l]
        h = h + moe_ffn(rmsnorm(h, norm_ffn_g[l]), w_router[l], b_router[l],
                        w_exp_gu[l], b_exp_gu[l], w_exp_down[l], b_exp_down[l])
    return rmsnorm(h, norm_final_g)[:, N_META:]
```

```cpp
#include <hip/hip_runtime.h>
#include <cstdio>
#include <cstdint>

#ifndef MK_WGM_INPROJ
#define MK_WGM_INPROJ 4
#endif
#ifndef MK_WGM_MOE
#define MK_WGM_MOE 8
#endif
#ifndef MK_SPLIT
#define MK_SPLIT 0
#endif

#define LAS __attribute__((address_space(3)))
typedef unsigned short bf16_t;
typedef short bf16x8 __attribute__((ext_vector_type(8)));
typedef float f32x4 __attribute__((ext_vector_type(4)));
typedef float f32x2 __attribute__((ext_vector_type(2)));
typedef unsigned u32x4 __attribute__((ext_vector_type(4)));
typedef unsigned u32x2 __attribute__((ext_vector_type(2)));

namespace mk {
constexpr int D = 1024, NBATCH = 8, SEQ = 4096, NMETA = 16, L = SEQ + NMETA, TR = NBATCH * SEQ  , MROW = TR  , PROWS = TR + NMETA;
constexpr int LDP = 8704;
constexpr int C_GQ = 0, C_GK = 512, C_GV = 1024, C_GR = 2048, C_RR = 3072, C_RK = 4096, C_RV = 5120, C_GG = 6144, C_GW = 7168,
              C_GA = 8192, C_RW = 8208, C_RA = 8272, C_RG = 8336;
constexpr int NE = 32;
constexpr float EPS = 1e-5f;
constexpr int NPHASE = 12;
__device__ __forceinline__ int prow(int b, int l) { return l < NMETA ? MROW + l : b * SEQ + (l - NMETA); }
constexpr size_t MiB = (size_t)1 << 20;
constexpr size_t WS_BAR = 0;
constexpr size_t WS_CNT = 16 * 1024;
constexpr size_t WS_MISC = 64 * 1024;
constexpr size_t WS_TOPE = 1 * MiB, WS_TOPC = 2 * MiB, WS_POS = 3 * MiB, WS_TOK = 4 * MiB, WS_CW = 5 * MiB;
constexpr size_t WS_WIN = 8 * MiB;
constexpr size_t WS_WGR = 25 * MiB;
constexpr size_t WS_WOUT = 29 * MiB;
constexpr size_t WS_WDEC = 31 * MiB;
constexpr size_t WS_WA2 = 31 * MiB + 128 * 1024;
constexpr size_t WS_WG2 = 31 * MiB + 256 * 1024;
constexpr size_t WS_WRS = 31 * MiB + 704 * 1024;
constexpr size_t WS_XB = 32 * MiB;
constexpr size_t WS_P = 96 * MiB;
constexpr size_t WS_ACT = WS_P, WS_YS = WS_P + 272 * MiB;
constexpr size_t WS_LORA = 641 * MiB;
constexpr size_t LSLOT = 65 * MiB;
constexpr size_t WS_MIX = WS_LORA;
constexpr size_t WS_WGU = WS_LORA;
constexpr size_t WS_U2 = WS_LORA + 130 * MiB;
constexpr size_t WS_WDN = WS_XB;
constexpr size_t WS_R5 = 836 * MiB;
constexpr size_t WS_END = 964 * MiB;
constexpr size_t WS_TAIL = WS_END;

constexpr int LDS_BYTES = 147456;
constexpr int LDS_MISC = 147200;

struct Args { const float* in[34]; float* out; unsigned char* ws; int ph_lo, ph_hi, flags, ntail; };

__device__ __forceinline__ float bf_lo(unsigned w) { return __uint_as_float(w << 16); }
__device__ __forceinline__ float bf_hi(unsigned w) { return __uint_as_float(w & 0xffff0000u); }
__device__ __forceinline__ float bf1(bf16_t v) { return __uint_as_float(((unsigned)v) << 16); }
typedef __bf16 bf16v2 __attribute__((ext_vector_type(2)));
__device__ __forceinline__ unsigned pk2(float lo, float hi) { bf16v2 v; v.x = (__bf16)lo; v.y = (__bf16)hi; return __builtin_bit_cast(unsigned, v); }
__device__ __forceinline__ unsigned f2bf(float f) { const __bf16 b = (__bf16)f; return (unsigned)__builtin_bit_cast(unsigned short, b); }
__device__ __forceinline__ float sigmoidf_(float x) { return __builtin_amdgcn_rcpf(1.0f + __expf(-x)); }
__device__ __forceinline__ float tanhf_(float x) { return 1.0f - 2.0f * __builtin_amdgcn_rcpf(1.0f + __expf(2.0f * x)); }
__device__ __forceinline__ float wave_sum(float v) {
#pragma unroll
    for (int o = 1; o < 64; o <<= 1) v += __shfl_xor(v, o);
    return v;
}
__device__ __forceinline__ int tidx() { int t = threadIdx.x; asm volatile("" : "+v"(t)); return t; }
__device__ __forceinline__ float red16(float v) { v += __shfl_xor(v, 1); v += __shfl_xor(v, 2); v += __shfl_xor(v, 4); v += __shfl_xor(v, 8); return v; }
template <int CTRL> __device__ __forceinline__ float dppf(float v) { return __int_as_float(__builtin_amdgcn_update_dpp(0, __float_as_int(v), CTRL, 0xF, 0xF, true)); }
__device__ __forceinline__ float red8(float v) { v += dppf<0xB1>(v); v += dppf<0x4E>(v); v += dppf<0x141>(v); return v; }

#define XB_TMO      128
#define XB_XCNT(j)  (256  + 64 * (j))
#define XB_XSUB(j)  (1280 + 64 * (j))
#define XB_XGEN(j)  (2304 + 64 * (j))
#define XB_TOP      3328
#define XB_TOPGEN   3392
#define XCD_BAR_WORDS 3456
#define XB_RDY      3456
#define XB_SPIN_CAP (1u << 22)
__device__ __forceinline__ unsigned xb_ld(unsigned* p)              { return __hip_atomic_load(p, __ATOMIC_RELAXED, __HIP_MEMORY_SCOPE_AGENT); }
__device__ __forceinline__ unsigned xb_add(unsigned* p, unsigned v) { return __hip_atomic_fetch_add(p, v, __ATOMIC_RELAXED, __HIP_MEMORY_SCOPE_AGENT); }
__device__ __forceinline__ unsigned xb_xcc_id() { return (unsigned)__builtin_amdgcn_s_getreg((3 << 11) | 20) & 0xFu; }
#define XB_SPIN(cond, bar) do { unsigned _sp = 0; while (cond) { __builtin_amdgcn_s_sleep(1); \
    if ((++_sp & 255u) == 0u) { if (xb_ld(&(bar)[XB_TMO])) break; if (_sp > XB_SPIN_CAP) { atomicAdd(&(bar)[XB_TMO], 1u); break; } } } } while (0)
struct XcdBarrier { unsigned* bar; unsigned x; volatile LAS unsigned* st; };
__device__ __forceinline__ XcdBarrier xcd_barrier_post(unsigned* bar, volatile LAS unsigned* st) {
    XcdBarrier b; b.bar = bar; b.x = xb_xcc_id(); b.st = st;
    if (threadIdx.x == 0) (void)xb_add(&bar[XB_XCNT(b.x)], 1u);
    return b;
}
__device__ __forceinline__ void xcd_barrier_complete(unsigned* bar, unsigned x, unsigned& nloc, unsigned& nx) {
    const unsigned G = gridDim.x * gridDim.y * gridDim.z;
    unsigned sum, cnt, mine, sp = 0u;
    for (;;) {
        sum = 0u; cnt = 0u; mine = 0u;
#pragma unroll
        for (unsigned j = 0; j < 16; ++j) { const unsigned c = xb_ld(&bar[XB_XCNT(j)]); sum += c; cnt += (c > 0u) ? 1u : 0u; mine = (j == x) ? c : mine; }
        if (sum == G) break;
        __builtin_amdgcn_s_sleep(1);
        if ((++sp & 255u) == 0u) { if (xb_ld(&bar[XB_TMO])) break; if (sp > XB_SPIN_CAP) { atomicAdd(&bar[XB_TMO], 1u); break; } }
    }
    nloc = mine > 0u ? mine : 1u; nx = cnt > 0u ? cnt : 1u;
}
__device__ __forceinline__ void xcd_barrier(const XcdBarrier& b) {
    asm volatile("s_waitcnt vmcnt(0)" ::: "memory");
    __syncthreads();
    if (threadIdx.x == 0) {
        unsigned* bar = b.bar;
        __builtin_amdgcn_s_waitcnt(0);
        unsigned nloc = b.st[0], nx = b.st[1];
        if (nloc == 0u) { xcd_barrier_complete(bar, b.x, nloc, nx); b.st[0] = nloc; b.st[1] = nx; }
        const unsigned old = xb_add(&bar[XB_XSUB(b.x)], 1u);
        const unsigned gen = old / nloc;
        if (old + 1u == (gen + 1u) * nloc) {
            __builtin_amdgcn_fence(__ATOMIC_RELEASE, "agent");
            asm volatile("s_waitcnt vmcnt(0)" ::: "memory");
            const unsigned og = xb_add(&bar[XB_TOP], 1u);
            const unsigned tg = og / nx;
            if (og + 1u == (tg + 1u) * nx) xb_add(&bar[XB_TOPGEN], 1u);
            else XB_SPIN(xb_ld(&bar[XB_TOPGEN]) == tg, bar);
            __builtin_amdgcn_fence(__ATOMIC_ACQUIRE, "agent");
            xb_add(&bar[XB_XGEN(b.x)], 1u);
            asm volatile("s_waitcnt vmcnt(0)" ::: "memory");
        } else {
            XB_SPIN(xb_ld(&bar[XB_XGEN(b.x)]) == gen, bar);
            __builtin_amdgcn_fence(__ATOMIC_ACQUIRE, "agent");
            asm volatile("s_waitcnt vmcnt(0)" ::: "memory");
        }
    }
    __syncthreads();
}

namespace pg8 {
constexpr int BM = 256, BK = 64, HALF = 128, HTB = HALF * BK * 2, STAGE_BYTES = 8 * HTB, NXCD = 8, WGM = 8;
__host__ __device__ __forceinline__ int lds_byte(int r, int c) { const int st = (r >> 4) * 2 + (c >> 5), rr = r & 15, cc = c & 31, ob = rr * 64 + cc * 2; return st * 1024 + (ob ^ (((ob >> 9) & 1) << 5)); }
__host__ __device__ __forceinline__ void stage_rc(int b, int& R, int& C) { const int st = b / 1024, sb = b % 1024, swz = sb ^ (((sb >> 9) & 1) << 5); R = (st >> 1) * 16 + swz / 64; C = (st & 1) * 32 + (swz % 64) / 2; }
__host__ __device__ __forceinline__ int perm32(int rho) { const int n = rho >> 4, i = rho & 15; return 8 * (i >> 2) + 4 * n + (i & 3); }
struct Unit { int pm, pn, e; };
struct StaticOrder {
    int nM, nN, nwg, G, c, wgm;
    __device__ __forceinline__ void init(int nM_, int nN_, int G_, int c_, int wgm_ = WGM) { nM = nM_; nN = nN_; nwg = nM * nN; G = G_; c = c_; wgm = wgm_; }
    __device__ __forceinline__ bool next(int i, Unit& u) const {
        const long Lx = (long)i * G + c; if (Lx >= nwg) return false;
        int wgid = (int)Lx; { const int q = nwg / NXCD, r = nwg % NXCD, xcd = wgid % NXCD, off = wgid / NXCD; wgid = (xcd < r ? xcd * (q + 1) : r * (q + 1) + (xcd - r) * q) + off; }
        const int nig = wgm * nN, gid = wgid / nig, fm = gid * wgm, gsz = (nM - fm) < wgm ? (nM - fm) : wgm;
        u.pm = fm + ((wgid % nig) % gsz); u.pn = (wgid % nig) / gsz; return true;
    }
};
__device__ __forceinline__ unsigned cvt_pk_bf16(float lo, float hi) { return pk2(lo, hi); }

struct ProbDense {
    const bf16_t* A; int lda; const bf16_t* Bt; int ldb; StaticOrder so;
    __device__ __forceinline__ bool next(int i, Unit& u) const { u.e = 0; return so.next(i, u); }
    __device__ __forceinline__ const char* a_base(const Unit& u) const { return (const char*)(A + (size_t)u.pm * 256 * lda); }
    __device__ __forceinline__ const char* b_base(const Unit& u) const { return (const char*)(Bt + (size_t)u.pn * 256 * ldb); }
    __device__ __forceinline__ void a_ready(int, const Unit&, int) const {}
    __device__ __forceinline__ void a_off(const Unit&, const int (&R)[2], const int (&C)[2], unsigned (&v)[2][2]) const {
#pragma unroll
        for (int h = 0; h < 2; ++h)
#pragma unroll
            for (int i = 0; i < 2; ++i) v[h][i] = (unsigned)(((h * HALF + R[i]) * lda + C[i]) * 2);
    }
};
struct ProbMix {
    const bf16_t* A; const bf16_t* Bt; StaticOrder so;
    __device__ __forceinline__ bool next(int i, Unit& u) const { if (!so.next(i >> 1, u)) return false; u.e = i & 1; return true; }
    __device__ __forceinline__ const char* a_base(const Unit& u) const { return (const char*)(A + (size_t)u.pm * 256 * 2048 + u.e * 1024); }
    __device__ __forceinline__ const char* b_base(const Unit& u) const { return (const char*)(Bt + (size_t)u.e * 1024 * 1024 + (size_t)u.pn * 256 * 1024); }
    __device__ __forceinline__ void a_ready(int, const Unit&, int) const {}
    __device__ __forceinline__ void a_off(const Unit&, const int (&R)[2], const int (&C)[2], unsigned (&v)[2][2]) const {
#pragma unroll
        for (int h = 0; h < 2; ++h)
#pragma unroll
            for (int i = 0; i < 2; ++i) v[h][i] = (unsigned)(((h * HALF + R[i]) * 2048 + C[i]) * 2);
    }
};
struct ProbMoE {
    const bf16_t* A; const int* tok; const bf16_t* Bt; const bf16_t* Bt2; int ntail; int nN; const int* tile2e; StaticOrder so;
    unsigned* rdy; unsigned need, mask;
    __device__ __forceinline__ void a_ready(int i, const Unit& u, int wid) const {
        if (rdy == nullptr || (i < 32 && ((mask >> i) & 1u))) return;
        if (wid == 0) { unsigned sp = 0u;
            while ((unsigned)__builtin_amdgcn_readfirstlane(xb_ld(rdy + u.pm)) < need) { __builtin_amdgcn_s_sleep(2); if (++sp > XB_SPIN_CAP) break; }
            __builtin_amdgcn_fence(__ATOMIC_ACQUIRE, "agent");
            asm volatile("s_waitcnt vmcnt(0)" ::: "memory"); }
        asm volatile("" ::: "memory"); __builtin_amdgcn_s_barrier(); asm volatile("" ::: "memory");
    }
    __device__ __forceinline__ bool next(int i, Unit& u) const { if (!so.next(i, u)) return false; u.e = __builtin_amdgcn_readfirstlane(tile2e[u.pm]); return true; }
    __device__ __forceinline__ const char* a_base(const Unit& u) const { return tok ? (const char*)A : (const char*)(A + (size_t)u.pm * 256 * 1024); }
    __device__ __forceinline__ const char* b_base(const Unit& u) const { return (u.e < ntail) ? (const char*)(Bt2 + ((size_t)u.e * nN + u.pn) * 256 * 1024) : (const char*)(Bt + ((size_t)(u.e - ntail) * nN + u.pn) * 256 * 1024); }
    __device__ __forceinline__ void a_off(const Unit& u, const int (&R)[2], const int (&C)[2], unsigned (&v)[2][2]) const {
#pragma unroll
        for (int h = 0; h < 2; ++h)
#pragma unroll
            for (int i = 0; i < 2; ++i) { const int row = tok ? tok[u.pm * 256 + h * HALF + R[i]] : (h * HALF + R[i]); v[h][i] = (unsigned)((row * 1024 + C[i]) * 2); }
    }
};

typedef f32x4 Acc[2][2][4][2];

template <class Epi, class Prob, int K>
__device__ __forceinline__ void gemm_phase(LAS unsigned char* lds, const Prob& S, const Epi& E) {
    const int tid = tidx(), wid = __builtin_amdgcn_readfirstlane(tid >> 6), lane = tid & 63, wr = wid >> 2, wc = wid & 3, fr = lane & 15, fq = lane >> 4;
    constexpr int nt = K / BK;
    int R[2], C[2]; unsigned voffB[2];
#pragma unroll
    for (int i = 0; i < 2; ++i) { stage_rc(tid * 16 + i * 8192, R[i], C[i]); const int Rb = Epi::PERM ? ((R[i] & ~31) + perm32(R[i] & 31)) : R[i]; voffB[i] = (unsigned)(Rb * K + C[i]) * 2u; }
    const size_t kstep = (size_t)(BK * 2);
    const size_t hstep = (size_t)HALF * K * 2;
    const unsigned ldsw = (unsigned)wid * 1024u;
    const int aoff = lds_byte(wr * 64 + fr, fq * 8), boff = lds_byte(wc * 32 + fr, fq * 8);
#define PG8_SA(b, h) (((b) * 2 + (h)) * HTB)
#define PG8_SB(b, h) ((4 + (b) * 2 + (h)) * HTB)
#define PG8_STAGE(bufoff, gbase, voff) do { _Pragma("unroll") for (int _i = 0; _i < 2; ++_i) \
        __builtin_amdgcn_global_load_lds((const unsigned*)((const char*)(gbase) + (voff)[_i]), (LAS unsigned*)(lds + (bufoff) + ldsw + _i * 8192), 16, 0, 0); } while (0)
#define PG8_LDA(dst, b, h) do { _Pragma("unroll") for (int m = 0; m < 4; ++m) _Pragma("unroll") for (int k = 0; k < 2; ++k) dst[m][k] = *(const LAS bf16x8*)(lds + PG8_SA(b, h) + aoff + m * 2048 + k * 1024); } while (0)
#define PG8_LDB(dst, b, h) do { _Pragma("unroll") for (int n = 0; n < 2; ++n) _Pragma("unroll") for (int k = 0; k < 2; ++k) dst[n][k] = *(const LAS bf16x8*)(lds + PG8_SB(b, h) + boff + n * 2048 + k * 1024); } while (0)
#define PG8_MMA(ai, bj, At, Bt) do { __builtin_amdgcn_s_setprio(1); _Pragma("unroll") for (int m = 0; m < 4; ++m) _Pragma("unroll") for (int n = 0; n < 2; ++n) _Pragma("unroll") for (int k = 0; k < 2; ++k) \
        acc[ai][bj][m][n] = __builtin_amdgcn_mfma_f32_16x16x32_bf16(Bt[n][k], At[m][k], acc[ai][bj][m][n], 0, 0, 0); __builtin_amdgcn_s_setprio(0); } while (0)
#define PG8_WAIT_V(n) asm volatile("s_waitcnt vmcnt(" #n ")" ::: "memory")
#define PG8_WAIT_L(n) asm volatile("s_waitcnt lgkmcnt(" #n ")" ::: "memory")
#define PG8_BAR __builtin_amdgcn_s_barrier()
#define PG8_SCHED __builtin_amdgcn_sched_barrier(0)
    Unit cur, nxt; int ui = 0;
    if (!S.next(0, cur)) return;
    Acc acc;
#pragma unroll
    for (int a = 0; a < 2; ++a)
#pragma unroll
        for (int b = 0; b < 2; ++b)
#pragma unroll
            for (int m = 0; m < 4; ++m)
#pragma unroll
                for (int n = 0; n < 2; ++n) acc[a][b][m][n] = (f32x4){0.f, 0.f, 0.f, 0.f};
    bf16x8 At[4][2], B0[2][2], B1[2][2];
    unsigned va[2][2], vn[2][2];
    S.a_off(cur, R, C, va);
    const char* cA = S.a_base(cur); const char* cB = S.b_base(cur);
    int pend = -1;
    S.a_ready(0, cur, wid);
    PG8_STAGE(PG8_SB(0, 0), cB, voffB); PG8_STAGE(PG8_SB(0, 1), cB + hstep, voffB); PG8_STAGE(PG8_SA(0, 0), cA, va[0]); PG8_STAGE(PG8_SA(0, 1), cA, va[1]);
    if (wr == 1) PG8_BAR;
    PG8_WAIT_V(2); PG8_BAR;
    PG8_STAGE(PG8_SB(1, 0), cB + kstep, voffB); PG8_STAGE(PG8_SA(1, 0), cA + kstep, va[0]); PG8_STAGE(PG8_SB(1, 1), cB + hstep + kstep, voffB);
    PG8_WAIT_V(6); PG8_BAR;
    for (;;) {
        const bool has_next = S.next(ui + 1, nxt);
        const char* nA = cA; const char* nB = cB;
#pragma unroll
        for (int h = 0; h < 2; ++h)
#pragma unroll
            for (int i = 0; i < 2; ++i) vn[h][i] = va[h][i];
        if (has_next) { nA = S.a_base(nxt); nB = S.b_base(nxt); S.a_off(nxt, R, C, vn); }
        for (int t = 0; t < nt; t += 2) {
            const bool last = (t == nt - 2);
            const char* a1 = cA + (size_t)(t + 1) * kstep;
            const char* a2 = last ? nA : cA + (size_t)(t + 2) * kstep; const char* b2 = last ? nB : cB + (size_t)(t + 2) * kstep;
            const char* a3 = a2 + kstep; const char* b3 = b2 + kstep;
            unsigned v2[2][2];
#pragma unroll
            for (int h = 0; h < 2; ++h)
#pragma unroll
                for (int i = 0; i < 2; ++i) v2[h][i] = last ? vn[h][i] : va[h][i];
            if constexpr (Epi::PUB) { if (t == 4 && pend >= 0) { E.publish(pend, lane); pend = -1; } }
            if (last && has_next) S.a_ready(ui + 1, nxt, wid);
            PG8_LDB(B0, 0, 0); PG8_LDB(B1, 0, 1); PG8_SCHED; PG8_LDA(At, 0, 0); PG8_STAGE(PG8_SA(1, 1), a1, va[1]);
            PG8_WAIT_V(8); PG8_WAIT_L(0); PG8_BAR; PG8_MMA(0, 0, At, B0); PG8_MMA(0, 1, At, B1); PG8_BAR; PG8_SCHED;
            PG8_LDA(At, 0, 1); PG8_STAGE(PG8_SB(0, 0), b2, voffB); PG8_STAGE(PG8_SB(0, 1), b2 + hstep, voffB); PG8_STAGE(PG8_SA(0, 0), a2, v2[0]);
            PG8_WAIT_V(8); PG8_WAIT_L(0); PG8_BAR; PG8_MMA(1, 0, At, B0); PG8_MMA(1, 1, At, B1); PG8_BAR; PG8_SCHED;
            PG8_LDB(B0, 1, 0); PG8_LDB(B1, 1, 1); PG8_SCHED; PG8_LDA(At, 1, 0); PG8_STAGE(PG8_SA(0, 1), a2, v2[1]);
            PG8_WAIT_V(8); PG8_WAIT_L(0); PG8_BAR; PG8_MMA(0, 0, At, B0); PG8_MMA(0, 1, At, B1); PG8_BAR; PG8_SCHED;
            PG8_LDA(At, 1, 1); PG8_STAGE(PG8_SB(1, 0), b3, voffB); PG8_STAGE(PG8_SB(1, 1), b3 + hstep, voffB); PG8_STAGE(PG8_SA(1, 0), a3, v2[0]);
            PG8_WAIT_V(8); PG8_WAIT_L(0); PG8_BAR; PG8_MMA(1, 0, At, B0); PG8_MMA(1, 1, At, B1); PG8_BAR; PG8_SCHED;
        }
        if (wr == 0) PG8_BAR;
        E(acc, cur, wr, wc, fr, fq);
        if constexpr (Epi::PUB) pend = cur.pm;
        if (!has_next) break;
        if (!(Epi::KEEP && cur.e == 0)) {
#pragma unroll
        for (int a = 0; a < 2; ++a)
#pragma unroll
            for (int b = 0; b < 2; ++b)
#pragma unroll
                for (int m = 0; m < 4; ++m)
#pragma unroll
                    for (int n = 0; n < 2; ++n) acc[a][b][m][n] = (f32x4){0.f, 0.f, 0.f, 0.f};
        }
        cur = nxt; cA = nA; cB = nB; ++ui;
#pragma unroll
        for (int h = 0; h < 2; ++h)
#pragma unroll
            for (int i = 0; i < 2; ++i) va[h][i] = vn[h][i];
        if (wr == 1) PG8_BAR;
    }
    PG8_WAIT_V(0);
    if constexpr (Epi::PUB) { if (pend >= 0) E.publish(pend, lane); }
    PG8_BAR;
#undef PG8_SA
#undef PG8_SB
#undef PG8_STAGE
#undef PG8_LDA
#undef PG8_LDB
#undef PG8_MMA
#undef PG8_WAIT_V
#undef PG8_WAIT_L
#undef PG8_BAR
#undef PG8_SCHED
}

struct EpiBf16 {
    static constexpr bool PERM = true, KEEP = false, PUB = false; static constexpr int NST = 16;
    bf16_t* O; int ldc;
    __device__ __forceinline__ void operator()(Acc& acc, const Unit& u, int wr, int wc, int fr, int fq) const {
        const int row0 = u.pm * BM + wr * 64 + fr, col0 = u.pn * BM + wc * 32 + 8 * fq;
#pragma unroll
        for (int ai = 0; ai < 2; ++ai)
#pragma unroll
            for (int m = 0; m < 4; ++m) { bf16_t* rowp = O + (size_t)(row0 + ai * HALF + m * 16) * ldc + col0;
#pragma unroll
                for (int bj = 0; bj < 2; ++bj) { const f32x4 v0 = acc[ai][bj][m][0], v1 = acc[ai][bj][m][1];
                    u32x4 w; w.x = cvt_pk_bf16(v0[0], v0[1]); w.y = cvt_pk_bf16(v0[2], v0[3]); w.z = cvt_pk_bf16(v1[0], v1[1]); w.w = cvt_pk_bf16(v1[2], v1[3]);
                    *(u32x4*)(rowp + bj * HALF) = w; } }
    }
};
struct EpiMix {
    static constexpr bool PERM = true, KEEP = true, PUB = false; static constexpr int NST = 16;
    const bf16_t* P; bf16_t* O;
    __device__ __forceinline__ void operator()(Acc& acc, const Unit& u, int wr, int wc, int fr, int fq) const { if (u.e == 0) first(acc, u, wr, wc, fr, fq); else second(acc, u, wr, wc, fr, fq); }
    __device__ __forceinline__ void first(Acc& acc, const Unit& u, int wr, int wc, int fr, int fq) const {
        const int row0 = u.pm * BM + wr * 64 + fr, col0 = u.pn * BM + wc * 32 + 8 * fq;
#pragma unroll
        for (int ai = 0; ai < 2; ++ai)
#pragma unroll
            for (int m = 0; m < 4; ++m) { const bf16_t* rowp = P + (size_t)(row0 + ai * HALF + m * 16) * LDP + col0;
#pragma unroll
                for (int bj = 0; bj < 2; ++bj) {
                    const u32x4 g1 = *(const u32x4*)(rowp + C_GG + bj * HALF), g2 = *(const u32x4*)(rowp + C_GW + bj * HALF);
                    float a[8], b[8];
                    a[0] = bf_lo(g1.x); a[1] = bf_hi(g1.x); a[2] = bf_lo(g1.y); a[3] = bf_hi(g1.y); a[4] = bf_lo(g1.z); a[5] = bf_hi(g1.z); a[6] = bf_lo(g1.w); a[7] = bf_hi(g1.w);
                    b[0] = bf_lo(g2.x); b[1] = bf_hi(g2.x); b[2] = bf_lo(g2.y); b[3] = bf_hi(g2.y); b[4] = bf_lo(g2.z); b[5] = bf_hi(g2.z); b[6] = bf_lo(g2.w); b[7] = bf_hi(g2.w);
#pragma unroll
                    for (int j = 0; j < 8; ++j) { const float ratio = (1.0f + __expf(-b[j])) * __builtin_amdgcn_rcpf(1.0f + __expf(-a[j])); acc[ai][bj][m][j >> 2][j & 3] *= ratio; }
                } }
    }
    __device__ __forceinline__ void second(Acc& acc, const Unit& u, int wr, int wc, int fr, int fq) const {
        const int row0 = u.pm * BM + wr * 64 + fr, col0 = u.pn * BM + wc * 32 + 8 * fq;
#pragma unroll
        for (int ai = 0; ai < 2; ++ai)
#pragma unroll
            for (int m = 0; m < 4; ++m) { const size_t r = (size_t)(row0 + ai * HALF + m * 16);
#pragma unroll
                for (int bj = 0; bj < 2; ++bj) {
                    const u32x4 g2 = *(const u32x4*)(P + r * LDP + col0 + C_GW + bj * HALF);
                    float b[8];
                    b[0] = bf_lo(g2.x); b[1] = bf_hi(g2.x); b[2] = bf_lo(g2.y); b[3] = bf_hi(g2.y); b[4] = bf_lo(g2.z); b[5] = bf_hi(g2.z); b[6] = bf_lo(g2.w); b[7] = bf_hi(g2.w);
                    float o[8];
#pragma unroll
                    for (int j = 0; j < 8; ++j) o[j] = acc[ai][bj][m][j >> 2][j & 3] * sigmoidf_(b[j]);
                    u32x4 w; w.x = cvt_pk_bf16(o[0], o[1]); w.y = cvt_pk_bf16(o[2], o[3]); w.z = cvt_pk_bf16(o[4], o[5]); w.w = cvt_pk_bf16(o[6], o[7]);
                    *(u32x4*)(O + r * D + col0 + bj * HALF) = w; } }
    }
};
struct EpiH2 {
    static constexpr bool PERM = true, KEEP = false, PUB = false; static constexpr int NST = 16;
    const float* x; bf16_t* O;
    __device__ __forceinline__ void operator()(Acc& acc, const Unit& u, int wr, int wc, int fr, int fq) const {
        const int row0 = u.pm * BM + wr * 64 + fr, col0 = u.pn * BM + wc * 32 + 8 * fq;
        u32x4 pk[2][4][2];
#pragma unroll
        for (int ai = 0; ai < 2; ++ai)
#pragma unroll
            for (int m = 0; m < 4; ++m)
#pragma unroll
                for (int bj = 0; bj < 2; ++bj) { const f32x4 v0 = acc[ai][bj][m][0], v1 = acc[ai][bj][m][1];
                    pk[ai][m][bj] = (u32x4){cvt_pk_bf16(v0[0], v0[1]), cvt_pk_bf16(v0[2], v0[3]), cvt_pk_bf16(v1[0], v1[1]), cvt_pk_bf16(v1[2], v1[3])}; }
#pragma unroll
        for (int ai = 0; ai < 2; ++ai) {
            f32x4 xv[4][2][2];
#pragma unroll
            for (int m = 0; m < 4; ++m)
#pragma unroll
                for (int bj = 0; bj < 2; ++bj) { const float* src = x + (size_t)(row0 + ai * HALF + m * 16) * D + col0 + bj * HALF; xv[m][bj][0] = *(const f32x4*)src; xv[m][bj][1] = *(const f32x4*)(src + 4); }
#pragma unroll
            for (int m = 0; m < 4; ++m)
#pragma unroll
                for (int bj = 0; bj < 2; ++bj) { const u32x4 q = pk[ai][m][bj]; const f32x4 a0 = xv[m][bj][0], a1 = xv[m][bj][1];
                    u32x4 w; w.x = cvt_pk_bf16(a0[0] + bf_lo(q.x), a0[1] + bf_hi(q.x)); w.y = cvt_pk_bf16(a0[2] + bf_lo(q.y), a0[3] + bf_hi(q.y));
                    w.z = cvt_pk_bf16(a1[0] + bf_lo(q.z), a1[1] + bf_hi(q.z)); w.w = cvt_pk_bf16(a1[2] + bf_lo(q.w), a1[3] + bf_hi(q.w));
                    *(u32x4*)(O + (size_t)(row0 + ai * HALF + m * 16) * D + col0 + bj * HALF) = w; }
        }
    }
};
struct EpiSwiglu {
    static constexpr bool PERM = true, KEEP = false, PUB = true; static constexpr int NST = 8;
    const float* bgu; bf16_t* O; unsigned* rdy;
    __device__ __forceinline__ void publish(int pm, int lane) const { if (lane == 0) __hip_atomic_fetch_add(rdy + pm, 1u, __ATOMIC_RELAXED, __HIP_MEMORY_SCOPE_AGENT); }
    __device__ __forceinline__ void operator()(Acc& acc, const Unit& u, int wr, int wc, int fr, int fq) const {
        const int row0 = u.pm * BM + wr * 64 + fr, d0 = u.pn * HALF + wc * 32 + 8 * fq;
        const float* bg = bgu + (size_t)u.e * 2048 + d0;
        const __amdgpu_buffer_rsrc_t rs = __builtin_amdgcn_make_buffer_rsrc((void*)O, (short)0, 0x7ffffff0, 0x00020000);
        float bgate[8], bup[8];
        { const f32x4 t0 = *(const f32x4*)bg, t1 = *(const f32x4*)(bg + 4), t2 = *(const f32x4*)(bg + 1024), t3 = *(const f32x4*)(bg + 1028);
#pragma unroll
          for (int j = 0; j < 4; ++j) { bgate[j] = t0[j]; bgate[4 + j] = t1[j]; bup[j] = t2[j]; bup[4 + j] = t3[j]; } }
#pragma unroll
        for (int ai = 0; ai < 2; ++ai)
#pragma unroll
            for (int m = 0; m < 4; ++m) { const size_t r = (size_t)(row0 + ai * HALF + m * 16);
                float o[8];
#pragma unroll
                for (int j = 0; j < 8; ++j) {
                    float g = acc[ai][0][m][j >> 2][j & 3] + bgate[j], up = acc[ai][1][m][j >> 2][j & 3] + bup[j];
                    g = fminf(g, 7.0f); up = fminf(fmaxf(up, -7.0f), 7.0f);
                    o[j] = (up + 1.0f) * (g * sigmoidf_(1.702f * g)); }
                u32x4 w; w.x = cvt_pk_bf16(o[0], o[1]); w.y = cvt_pk_bf16(o[2], o[3]); w.z = cvt_pk_bf16(o[4], o[5]); w.w = cvt_pk_bf16(o[6], o[7]);
                __builtin_amdgcn_raw_buffer_store_b128(w, rs, (int)(((unsigned)r * D + d0) * 2u), 0, 16); }
    }
};
struct EpiDown {
    static constexpr bool PERM = true, KEEP = false, PUB = false; static constexpr int NST = 16;
    const float* bdn; const float* cw; bf16_t* O;
    __device__ __forceinline__ void operator()(Acc& acc, const Unit& u, int wr, int wc, int fr, int fq) const {
        const int row0 = u.pm * BM + wr * 64 + fr, col0 = u.pn * BM + wc * 32 + 8 * fq;
        const float* bb = bdn + (size_t)u.e * D + col0;
        float bias[2][8];
#pragma unroll
        for (int bj = 0; bj < 2; ++bj) { const f32x4 t0 = *(const f32x4*)(bb + bj * HALF), t1 = *(const f32x4*)(bb + bj * HALF + 4);
#pragma unroll
            for (int j = 0; j < 4; ++j) { bias[bj][j] = t0[j]; bias[bj][4 + j] = t1[j]; } }
#pragma unroll
        for (int ai = 0; ai < 2; ++ai)
#pragma unroll
            for (int m = 0; m < 4; ++m) { const size_t r = (size_t)(row0 + ai * HALF + m * 16); const float c = cw[r];
#pragma unroll
                for (int bj = 0; bj < 2; ++bj) { float o[8];
#pragma unroll
                    for (int j = 0; j < 8; ++j) o[j] = (acc[ai][bj][m][j >> 2][j & 3] + bias[bj][j]) * c;
                    u32x4 w; w.x = cvt_pk_bf16(o[0], o[1]); w.y = cvt_pk_bf16(o[2], o[3]); w.z = cvt_pk_bf16(o[4], o[5]); w.w = cvt_pk_bf16(o[6], o[7]);
                    *(u32x4*)(O + r * D + col0 + bj * HALF) = w; } }
    }
};
}

__device__ __forceinline__ int win_srccol(int n) {
    if (n < 3072) return n;
    if (n < 6144) return 3088 + (n - 3072);
    if (n < 8192) return 6448 + (n - 6144);
    if (n < 8208) return 3072 + (n - 8192);
    if (n < 8496) return 6160 + (n - 8208);
    return -1;
}
template <int MODE>
__device__ __forceinline__ void tr_item(const float* src, int ld, int kvalid, bf16_t* dst, int dld, int k0, int n0, const float* scale, int lane) {
    const int kr = lane >> 3, c4 = (lane & 7) * 4, n = n0 + c4, kb = k0 + 8 * kr;
    int sc;
    if (MODE == 0) sc = n; else if (MODE == 1) sc = win_srccol(n); else { const int pn = n >> 8, r = n & 255, d = pn * 128 + (r & 127); sc = (r < 128) ? d : 1024 + d; }
    f32x4 v[8];
#pragma unroll
    for (int i = 0; i < 8; ++i) { v[i] = (f32x4){0.f, 0.f, 0.f, 0.f}; if (sc >= 0 && kb + i < kvalid) v[i] = *(const f32x4*)(src + (size_t)(kb + i) * ld + sc); }
    if (scale) { const f32x4 s0 = *(const f32x4*)(scale + kb), s1 = *(const f32x4*)(scale + kb + 4);
#pragma unroll
        for (int i = 0; i < 4; ++i) { v[i] = v[i] * s0[i]; v[4 + i] = v[4 + i] * s1[i]; } }
#pragma unroll
    for (int j = 0; j < 4; ++j) {
        u32x4 o; o.x = pk2(v[0][j], v[1][j]); o.y = pk2(v[2][j], v[3][j]); o.z = pk2(v[4][j], v[5][j]); o.w = pk2(v[6][j], v[7][j]);
        *(u32x4*)(dst + (size_t)(n + j) * dld + kb) = o; }
}

__device__ __forceinline__ void phase_prologue(const Args& a, LAS unsigned char* lds) {
    unsigned char* ws = a.ws;
    const int tid = tidx(), wave = tid >> 6, lane = tid & 63;
    { const float* wrt = a.in[27]; const float* gfn = a.in[26]; bf16_t* wrs = (bf16_t*)(ws + WS_WRS);
      for (int i = blockIdx.x * 512 + tid; i < 1024 * 32; i += gridDim.x * 512) { const int k = i >> 5, e = i & 31; const float w = wrt[i] * gfn[k]; const unsigned hi = f2bf(w);
          wrs[e * 1024 + k] = (bf16_t)hi; wrs[32768 + e * 1024 + k] = (bf16_t)f2bf(w - bf1((bf16_t)hi)); } }
    const int gw = blockIdx.x * 8 + wave, NGW = gridDim.x * 8;
    constexpr int J_WIN = 16 * 272, J_SQ = 16 * 32, J_LR = 32, J_G2 = 96;
    constexpr int NJ = J_WIN + 3 * J_SQ + 2 * J_LR + J_G2;
    for (int job = gw; job < NJ; job += NGW) {
        int r = job;
        if (r < J_WIN) { tr_item<1>(a.in[3], 8496, 1024, (bf16_t*)(ws + WS_WIN), 1024, (r % 16) * 64, (r / 16) * 32, a.in[2], lane); continue; } r -= J_WIN;
        if (r < J_SQ) { tr_item<0>(a.in[7], 1024, 1024, (bf16_t*)(ws + WS_WGR), 1024, (r % 16) * 64, (r / 16) * 32, nullptr, lane); continue; } r -= J_SQ;
        if (r < J_SQ) { tr_item<0>(a.in[24], 1024, 1024, (bf16_t*)(ws + WS_WGR) + 1024 * 1024, 1024, (r % 16) * 64, (r / 16) * 32, nullptr, lane); continue; } r -= J_SQ;
        if (r < J_SQ) { tr_item<0>(a.in[25], 1024, 1024, (bf16_t*)(ws + WS_WOUT), 1024, (r % 16) * 64, (r / 16) * 32, nullptr, lane); continue; } r -= J_SQ;
        if (r < J_LR) { tr_item<0>(a.in[14], 1024, 64, (bf16_t*)(ws + WS_WDEC), 64, 0, r * 32, nullptr, lane); continue; } r -= J_LR;
        if (r < J_LR) { tr_item<0>(a.in[16], 1024, 64, (bf16_t*)(ws + WS_WA2), 64, 0, r * 32, nullptr, lane); continue; } r -= J_LR;
        tr_item<0>(a.in[18], 1024, 160, (bf16_t*)(ws + WS_WG2), 192, (r % 3) * 64, (r / 3) * 32, nullptr, lane);
    }
    bf16_t* XB = (bf16_t*)(ws + WS_XB);
    {
        f32x4 v[4], nv[4];
#pragma unroll
        for (int j = 0; j < 4; ++j) { v[j] = (gw < TR) ? ((const f32x4*)(a.in[0] + (size_t)gw * D))[lane + 64 * j] : (f32x4){0.f, 0.f, 0.f, 0.f}; nv[j] = v[j]; }
        for (int row = gw; row < TR; row += NGW) {
            const int nrow = row + NGW;
            if (nrow < TR) {
#pragma unroll
                for (int j = 0; j < 4; ++j) nv[j] = ((const f32x4*)(a.in[0] + (size_t)nrow * D))[lane + 64 * j]; }
            u32x2* o = (u32x2*)(XB + (size_t)row * D) + lane;
            float s = 0.f;
#pragma unroll
            for (int j = 0; j < 4; ++j) s += (v[j].x * v[j].x + v[j].y * v[j].y) + (v[j].z * v[j].z + v[j].w * v[j].w);
            const float rstd = rsqrtf(wave_sum(s) * (1.0f / D) + EPS);
#pragma unroll
            for (int j = 0; j < 4; ++j) { o[64 * j] = (u32x2){pk2(v[j].x * rstd, v[j].y * rstd), pk2(v[j].z * rstd, v[j].w * rstd)}; v[j] = nv[j]; }
        }
    }
    __syncthreads();
    LAS float* UM = (LAS float*)lds;
    LAS float* RED = UM + 1024 * 16;
    { const float* gmix = a.in[2];
#pragma unroll
      for (int rr = 0; rr < 2; ++rr) { const int l = wave * 2 + rr; const float* srcp = a.in[1] + (size_t)l * D; float x[16]; float s = 0.f;
#pragma unroll
          for (int m = 0; m < 16; ++m) { x[m] = srcp[lane + 64 * m]; s += x[m] * x[m]; }
          const float rstd = rsqrtf(wave_sum(s) * (1.0f / D) + EPS);
#pragma unroll
          for (int m = 0; m < 16; ++m) { const int k = lane + 64 * m; UM[k * 16 + l] = x[m] * rstd * gmix[k]; } } }
    __syncthreads();
    bf16_t* P = (bf16_t*)(ws + WS_P);
    for (int cg = blockIdx.x; cg < 256; cg += gridDim.x) {
        const int n0 = cg * 34, kq = tid >> 5, c = tid & 31;
        const int sA = win_srccol(n0 + c), sB = (c < 2) ? win_srccol(n0 + 32 + c) : -1;
        float accA[16], accB[16];
#pragma unroll
        for (int l = 0; l < 16; ++l) { accA[l] = 0.f; accB[l] = 0.f; }
#pragma unroll 4
        for (int k = kq; k < 1024; k += 16) {
            const float wA = (sA >= 0) ? a.in[3][(size_t)k * 8496 + sA] : 0.f, wB = (sB >= 0) ? a.in[3][(size_t)k * 8496 + sB] : 0.f;
            const f32x4 u0 = *(const LAS f32x4*)(UM + k * 16), u1 = *(const LAS f32x4*)(UM + k * 16 + 4), u2 = *(const LAS f32x4*)(UM + k * 16 + 8), u3 = *(const LAS f32x4*)(UM + k * 16 + 12);
#pragma unroll
            for (int j = 0; j < 4; ++j) { accA[j] += u0[j] * wA; accA[4 + j] += u1[j] * wA; accA[8 + j] += u2[j] * wA; accA[12 + j] += u3[j] * wA;
                                          accB[j] += u0[j] * wB; accB[4 + j] += u1[j] * wB; accB[8 + j] += u2[j] * wB; accB[12 + j] += u3[j] * wB; }
        }
#pragma unroll
        for (int l = 0; l < 16; ++l) { RED[(kq * 34 + c) * 16 + l] = accA[l]; if (c < 2) RED[(kq * 34 + 32 + c) * 16 + l] = accB[l]; }
        __syncthreads();
        for (int o = tid; o < 34 * 16; o += 512) { const int cc = o >> 4, l = o & 15; float s = 0.f;
#pragma unroll
            for (int q = 0; q < 16; ++q) s += RED[(q * 34 + cc) * 16 + l];
            P[(size_t)(MROW + l) * LDP + n0 + cc] = (bf16_t)f2bf(s); }
        __syncthreads();
    }
}

struct LoraW { bf16x8 w[2][2], a[2][2], g[2][6]; };
__device__ __forceinline__ void lora_ldw(LoraW& F, const bf16_t* WDEC, const bf16_t* WA2, const bf16_t* WG2, int p, int fr, int fq) {
#pragma unroll
    for (int u = 0; u < 2; ++u) { const int n = 32 * p + 8 * (fr >> 2) + 4 * u + (fr & 3);
#pragma unroll
        for (int ks = 0; ks < 2; ++ks) { F.w[u][ks] = *(const bf16x8*)(WDEC + n * 64 + ks * 32 + fq * 8); F.a[u][ks] = *(const bf16x8*)(WA2 + n * 64 + ks * 32 + fq * 8); }
#pragma unroll
        for (int ks = 0; ks < 6; ++ks) F.g[u][ks] = *(const bf16x8*)(WG2 + n * 192 + ks * 32 + fq * 8); }
}
__device__ __forceinline__ void phase_lora(const Args& a, LAS unsigned char* lds) {
    const int tid = tidx(), wave = tid >> 6, lane = tid & 63, fr = lane & 15, fq = lane >> 4;
    const bf16_t* P = (const bf16_t*)(a.ws + WS_P);
    const bf16_t* WDEC = (const bf16_t*)(a.ws + WS_WDEC); const bf16_t* WA2 = (const bf16_t*)(a.ws + WS_WA2); const bf16_t* WG2 = (const bf16_t*)(a.ws + WS_WG2);
    bf16_t* WLIN = (bf16_t*)(a.ws + WS_LORA); bf16_t* ALIN = (bf16_t*)(a.ws + WS_LORA + LSLOT); bf16_t* GLIN = (bf16_t*)(a.ws + WS_LORA + 2 * LSLOT);
    LAS bf16_t* Xw = (LAS bf16_t*)lds; LAS bf16_t* Xa = Xw + 128 * 72; LAS bf16_t* Xg = Xa + 128 * 72;
    const float* mu_w = a.in[11]; const float* mu_a = a.in[12]; const float* mu_g = a.in[13];
    for (int tile = blockIdx.x; tile <= TR / 128; tile += gridDim.x) {
        const bool meta = (tile == TR / 128);
        { const int rr = tid >> 2, qd = tid & 3;
          int t, tp;
          if (!meta) { t = tile * 128 + rr; tp = (t & (SEQ - 1)) ? t - 1 : MROW + NMETA - 1; }
          else { t = MROW + (rr & 15); tp = (rr & 15) ? t - 1 : -1; }
          const bool hp = tp >= 0;
          const bf16_t* cur = P + (size_t)t * LDP; const bf16_t* prv = P + (size_t)(hp ? tp : t) * LDP;
#pragma unroll
          for (int hf = 0; hf < 2; ++hf) { const int c = qd * 16 + hf * 8;
              { const u32x4 vc = *(const u32x4*)(cur + C_RW + c); u32x4 vp = (u32x4){0u, 0u, 0u, 0u}; if (hp) vp = *(const u32x4*)(prv + C_RW + c);
                float z[8]; const unsigned wc_[4] = {vc.x, vc.y, vc.z, vc.w}, wp_[4] = {vp.x, vp.y, vp.z, vp.w};
#pragma unroll
                for (int j = 0; j < 4; ++j) { const float c0 = bf_lo(wc_[j]), c1 = bf_hi(wc_[j]), p0 = bf_lo(wp_[j]), p1 = bf_hi(wp_[j]);
                    z[2 * j] = tanhf_(c0 + (p0 - c0) * mu_w[c + 2 * j]); z[2 * j + 1] = tanhf_(c1 + (p1 - c1) * mu_w[c + 2 * j + 1]); }
                *(LAS u32x4*)(Xw + rr * 72 + c) = (u32x4){pk2(z[0], z[1]), pk2(z[2], z[3]), pk2(z[4], z[5]), pk2(z[6], z[7])}; }
              { const u32x4 vc = *(const u32x4*)(cur + C_RA + c); u32x4 vp = (u32x4){0u, 0u, 0u, 0u}; if (hp) vp = *(const u32x4*)(prv + C_RA + c);
                float z[8]; const unsigned wc_[4] = {vc.x, vc.y, vc.z, vc.w}, wp_[4] = {vp.x, vp.y, vp.z, vp.w};
#pragma unroll
                for (int j = 0; j < 4; ++j) { const float c0 = bf_lo(wc_[j]), c1 = bf_hi(wc_[j]), p0 = bf_lo(wp_[j]), p1 = bf_hi(wp_[j]);
                    z[2 * j] = c0 + (p0 - c0) * mu_a[c + 2 * j]; z[2 * j + 1] = c1 + (p1 - c1) * mu_a[c + 2 * j + 1]; }
                *(LAS u32x4*)(Xa + rr * 72 + c) = (u32x4){pk2(z[0], z[1]), pk2(z[2], z[3]), pk2(z[4], z[5]), pk2(z[6], z[7])}; } }
#pragma unroll
          for (int ch = 0; ch < 5; ++ch) { const int c = qd * 40 + ch * 8;
              const u32x4 vc = *(const u32x4*)(cur + C_RG + c); u32x4 vp = (u32x4){0u, 0u, 0u, 0u}; if (hp) vp = *(const u32x4*)(prv + C_RG + c);
              float z[8]; const unsigned wc_[4] = {vc.x, vc.y, vc.z, vc.w}, wp_[4] = {vp.x, vp.y, vp.z, vp.w};
#pragma unroll
              for (int j = 0; j < 4; ++j) { const float c0 = bf_lo(wc_[j]), c1 = bf_hi(wc_[j]), p0 = bf_lo(wp_[j]), p1 = bf_hi(wp_[j]);
                  z[2 * j] = sigmoidf_(c0 + (p0 - c0) * mu_g[c + 2 * j]); z[2 * j + 1] = sigmoidf_(c1 + (p1 - c1) * mu_g[c + 2 * j + 1]); }
              *(LAS u32x4*)(Xg + rr * 200 + c) = (u32x4){pk2(z[0], z[1]), pk2(z[2], z[3]), pk2(z[4], z[5]), pk2(z[6], z[7])}; }
          *(LAS u32x4*)(Xg + rr * 200 + 160 + qd * 8) = (u32x4){0u, 0u, 0u, 0u};
        }
        __syncthreads();
        const int ngrp = meta ? 1 : 8;
        for (int pp = 0; pp < 4; ++pp) { const int p = wave * 4 + pp;
            LoraW F; lora_ldw(F, WDEC, WA2, WG2, p, fr, fq);
            for (int mg = 0; mg < ngrp; ++mg) { const int m0 = mg * 16;
                f32x4 cw[2], ca[2], cg[2];
#pragma unroll
                for (int u = 0; u < 2; ++u) { cw[u] = (f32x4){0.f, 0.f, 0.f, 0.f}; ca[u] = cw[u]; cg[u] = cw[u]; }
#pragma unroll
                for (int ks = 0; ks < 2; ++ks) { const bf16x8 xw = *(const LAS bf16x8*)(Xw + (m0 + fr) * 72 + ks * 32 + fq * 8), xa = *(const LAS bf16x8*)(Xa + (m0 + fr) * 72 + ks * 32 + fq * 8);
#pragma unroll
                    for (int u = 0; u < 2; ++u) { cw[u] = __builtin_amdgcn_mfma_f32_16x16x32_bf16(F.w[u][ks], xw, cw[u], 0, 0, 0); ca[u] = __builtin_amdgcn_mfma_f32_16x16x32_bf16(F.a[u][ks], xa, ca[u], 0, 0, 0); } }
#pragma unroll
                for (int ks = 0; ks < 6; ++ks) { const bf16x8 xg = *(const LAS bf16x8*)(Xg + (m0 + fr) * 200 + ks * 32 + fq * 8);
#pragma unroll
                    for (int u = 0; u < 2; ++u) cg[u] = __builtin_amdgcn_mfma_f32_16x16x32_bf16(F.g[u][ks], xg, cg[u], 0, 0, 0); }
                const size_t orow = (size_t)((meta ? MROW : tile * 128) + m0 + fr) * D; const int oc = 32 * p + 8 * fq;
                *(u32x4*)(WLIN + orow + oc) = (u32x4){pk2(cw[0][0], cw[0][1]), pk2(cw[0][2], cw[0][3]), pk2(cw[1][0], cw[1][1]), pk2(cw[1][2], cw[1][3])};
                *(u32x4*)(ALIN + orow + oc) = (u32x4){pk2(ca[0][0], ca[0][1]), pk2(ca[0][2], ca[0][3]), pk2(ca[1][0], ca[1][1]), pk2(ca[1][2], ca[1][3])};
                *(u32x4*)(GLIN + orow + oc) = (u32x4){pk2(cg[0][0], cg[0][1]), pk2(cg[0][2], cg[0][3]), pk2(cg[1][0], cg[1][1]), pk2(cg[1][2], cg[1][3])};
            }
        }
        __syncthreads();
    }
}

__device__ __forceinline__ int swzf(int row) { return ((row >> 1) & 7) ^ ((row >> 4) & 7); }
__device__ __forceinline__ int swz(int row, int col) { return row * 64 + ((((col >> 3) ^ swzf(row)) << 3) | (col & 7)); }
__device__ __forceinline__ bf16x8 ldfrag(const LAS bf16_t* M, int row, int kchunk) { return *(const LAS bf16x8*)(M + row * 64 + ((kchunk ^ swzf(row)) << 3)); }
__device__ __forceinline__ float frcp(float x) { return __builtin_amdgcn_rcpf(x); }
struct FragOff { int o0, o1; };
__device__ __forceinline__ FragOff mkfo(int T, int fr, int X) { FragOff f; f.o0 = T * 1024 + fr * 64 + (((T ^ X) & 7) << 3); f.o1 = f.o0 ^ 32; return f; }
#define LDF(M, fo, ks) (*(const LAS bf16x8*)((M) + ((ks) ? (fo).o1 : (fo).o0)))
#define LDF2(M, fo, ks) (*(const LAS bf16x8*)((M) + ((ks) >> 1) * 4096 + (((ks) & 1) ? (fo).o1 : (fo).o0)))

__device__ __forceinline__ void rwkv_item(const Args& a, LAS unsigned char* lds, int item) {
    const int tid = tidx(), wave = __builtin_amdgcn_readfirstlane(tid >> 6), lane = tid & 63, fr = lane & 15, fq = lane >> 4;
    const int b = item >> 4, h = item & 15;
    LAS bf16_t* ZA = (LAS bf16_t*)lds;
    LAS bf16_t* ZR = ZA + 4096;
    LAS bf16_t* XBm = ZR + 4096;
    LAS bf16_t* XK = XBm + 4096;
    LAS bf16_t* BTt = XK + 4096;
    LAS bf16_t* KTt = BTt + 4096;
    LAS bf16_t* VcT = KTt + 4096;
    LAS bf16_t* MakT = VcT + 4096;
    LAS bf16_t* NbrT = MakT + 4096;
    LAS bf16_t* NkrT = NbrT + 4096;
    LAS bf16_t* TIv = NkrT + 4096;
    LAS bf16_t* S0b = TIv + 4096;
    LAS bf16_t* U0b = S0b + 4096;
    LAS bf16_t* Ub = U0b + 4096;
    LAS float* CW = (LAS float*)(lds + 14 * 8192);
    LAS float* PTs = CW + 4096;
    LAS float* WCv = PTs + 512;
    LAS float* CST = WCv + 64;
    LAS bf16_t* PAb = (LAS bf16_t*)(CST + 640);
    LAS bf16_t* MA = U0b; LAS bf16_t* MAT = Ub; LAS bf16_t* MB = (LAS bf16_t*)CW; LAS bf16_t* MBT = MB + 4096;
    const bf16_t* P = (const bf16_t*)(a.ws + WS_P);
    const bf16_t* WLIN = (const bf16_t*)(a.ws + WS_LORA); const bf16_t* ALIN = (const bf16_t*)(a.ws + WS_LORA + LSLOT); const bf16_t* GLIN = (const bf16_t*)(a.ws + WS_LORA + 2 * LSLOT);
    bf16_t* A12 = (bf16_t*)(a.ws + WS_R5);
    const int ptt = tid >> 3, c8 = (tid & 7) * 8, col = h * 64 + c8;
    if (tid < 64) { const int cc = h * 64 + tid;
        CST[tid] = a.in[8][cc]; CST[64 + tid] = a.in[9][cc]; CST[128 + tid] = a.in[10][cc]; CST[192 + tid] = a.in[15][cc]; CST[256 + tid] = a.in[17][cc];
        CST[320 + tid] = a.in[19][cc]; CST[384 + tid] = a.in[20][cc]; CST[448 + tid] = a.in[21][cc]; CST[512 + tid] = a.in[22][cc]; CST[576 + tid] = a.in[23][cc]; }
#define CSTV(arr, idx) float arr[8]; { const f32x4 c0_ = *(const LAS f32x4*)(CST + (idx) * 64 + c8), c1_ = *(const LAS f32x4*)(CST + (idx) * 64 + c8 + 4); \
        arr[0] = c0_[0]; arr[1] = c0_[1]; arr[2] = c0_[2]; arr[3] = c0_[3]; arr[4] = c1_[0]; arr[5] = c1_[1]; arr[6] = c1_[2]; arr[7] = c1_[3]; }
    f32x4 st[2]; st[0] = (f32x4){0.f, 0.f, 0.f, 0.f}; st[1] = st[0];
    for (int i = tid; i < 2048; i += 512) ((LAS unsigned*)S0b)[i] = 0u;
    for (int i = tid; i < 4 * 2048; i += 512) ((LAS unsigned*)MakT)[i] = 0u;
    const int ii = wave >> 1, tb = 2 * (wave & 1);
    const u32x4 z4 = (u32x4){0u, 0u, 0u, 0u};
    u32x4 Lr, Lk, Lv, Lrp, Lkp, Lvp, Lw, La, Lg;
#define RW_LOAD(nn) do { const int l_ = (nn) * 64 + ptt; const bool v_ = l_ < L; const bool hp_ = v_ && l_ > 0; \
        Lr = z4; Lk = z4; Lv = z4; Lrp = z4; Lkp = z4; Lvp = z4; Lw = z4; La = z4; Lg = z4; \
        if (v_) { const size_t r_ = (size_t)prow(b, l_); const bf16_t* pc = P + r_ * LDP + col; const size_t lo = r_ * D + col; \
            Lr = *(const u32x4*)(pc + C_RR); Lk = *(const u32x4*)(pc + C_RK); Lv = *(const u32x4*)(pc + C_RV); \
            Lw = *(const u32x4*)(WLIN + lo); La = *(const u32x4*)(ALIN + lo); Lg = *(const u32x4*)(GLIN + lo); } \
        if (hp_) { const bf16_t* pp = P + (size_t)prow(b, l_ - 1) * LDP + col; Lrp = *(const u32x4*)(pp + C_RR); Lkp = *(const u32x4*)(pp + C_RK); Lvp = *(const u32x4*)(pp + C_RV); } } while (0)
    RW_LOAD(0);
    __syncthreads();
#define LDS_BAR() do { asm volatile("s_waitcnt lgkmcnt(0)" ::: "memory"); __builtin_amdgcn_s_barrier(); asm volatile("" ::: "memory"); } while (0)
#define CVT1(x) ((bf16_t)f2bf(x))
#define CVT4(v0, v1, v2, v3) ((u32x2){pk2((v0), (v1)), pk2((v2), (v3))})
    const int tid_outer = tid;
    for (int n = 0; n < 65; ++n) {
        int tid = tid_outer; asm volatile("" : "+v"(tid));
        const int lane = tid & 63, fr = lane & 15, fq = lane >> 4, ptt = tid >> 3, c8 = (tid & 7) * 8, tk = lane >> 3;
        const int fX = (fq ^ (fr >> 1)) & 7; const FragOff fI = mkfo(ii, fr, fX); const FragOff fT[2] = {mkfo(tb, fr, fX), mkfo(tb + 1, fr, fX)};
        const int l = n * 64 + ptt; const bool valid = l < L;
        float r[8], km[8], v[8], av[8], bv[8], g[8], lw[8], cwv[8], bonus;
        {
            const unsigned wr_[4] = {Lr.x, Lr.y, Lr.z, Lr.w}, wrp[4] = {Lrp.x, Lrp.y, Lrp.z, Lrp.w}, wk_[4] = {Lk.x, Lk.y, Lk.z, Lk.w}, wkp[4] = {Lkp.x, Lkp.y, Lkp.z, Lkp.w};
            const unsigned wv_[4] = {Lv.x, Lv.y, Lv.z, Lv.w}, wvp[4] = {Lvp.x, Lvp.y, Lvp.z, Lvp.w}, ww_[4] = {Lw.x, Lw.y, Lw.z, Lw.w}, wa_[4] = {La.x, La.y, La.z, La.w}, wg_[4] = {Lg.x, Lg.y, Lg.z, Lg.w};
            float k[8], asg[8], kkv[8]; float nrm = 0.f;
            CSTV(mur, 0) CSTV(muk, 1) CSTV(muv, 2) CSTV(bdec, 3) CSTV(ba, 4) CSTV(kkc, 5)
#pragma unroll
            for (int e = 0; e < 8; ++e) { const int q = e >> 1; const bool hi_ = e & 1;
                const float rc = hi_ ? bf_hi(wr_[q]) : bf_lo(wr_[q]), rp = hi_ ? bf_hi(wrp[q]) : bf_lo(wrp[q]);
                const float kc = hi_ ? bf_hi(wk_[q]) : bf_lo(wk_[q]), kp = hi_ ? bf_hi(wkp[q]) : bf_lo(wkp[q]);
                const float vc = hi_ ? bf_hi(wv_[q]) : bf_lo(wv_[q]), vp = hi_ ? bf_hi(wvp[q]) : bf_lo(wvp[q]);
                const float wl = hi_ ? bf_hi(ww_[q]) : bf_lo(ww_[q]), al = hi_ ? bf_hi(wa_[q]) : bf_lo(wa_[q]);
                g[e] = hi_ ? bf_hi(wg_[q]) : bf_lo(wg_[q]);
                r[e] = rc + (rp - rc) * mur[e]; k[e] = kc + (kp - kc) * muk[e]; v[e] = vc + (vp - vc) * muv[e];
                lw[e] = valid ? -0.6065306597126334f * frcp(1.0f + __expf(-(bdec[e] + wl))) : 0.f;
                asg[e] = frcp(1.0f + __expf(-(ba[e] + al)));
                kkv[e] = k[e] * kkc[e]; nrm += kkv[e] * kkv[e]; }
            nrm = red8(nrm);
            const float inv = rsqrtf(fmaxf(nrm, 1e-24f));
            float bn = 0.f;
            CSTV(kac, 6) CSTV(rkc, 7)
#pragma unroll
            for (int e = 0; e < 8; ++e) { const float kkn = kkv[e] * inv; km[e] = k[e] * (1.0f + (asg[e] - 1.0f) * kac[e]); av[e] = -kkn; bv[e] = kkn * asg[e]; bn += r[e] * km[e] * rkc[e]; }
            bonus = red8(bn);
#pragma unroll
            for (int e = 0; e < 8; ++e) { float x = lw[e];
                float y = __shfl_up(x, 8); x += (tk >= 1) ? y : 0.f;
                y = __shfl_up(x, 16); x += (tk >= 2) ? y : 0.f;
                y = __shfl_up(x, 32); x += (tk >= 4) ? y : 0.f;
                cwv[e] = x; }
            if (tk == 7) { *(LAS f32x4*)(PTs + wave * 64 + c8) = (f32x4){cwv[0], cwv[1], cwv[2], cwv[3]}; *(LAS f32x4*)(PTs + wave * 64 + c8 + 4) = (f32x4){cwv[4], cwv[5], cwv[6], cwv[7]}; }
        }
#pragma unroll
        for (int e = 0; e < 8; ++e) VcT[swz(c8 + e, ptt)] = CVT1(v[e]);
        LDS_BAR();
        { for (int p = 0; p < wave; ++p) { const f32x4 p0 = *(const LAS f32x4*)(PTs + p * 64 + c8), p1 = *(const LAS f32x4*)(PTs + p * 64 + c8 + 4);
#pragma unroll
              for (int e = 0; e < 4; ++e) { cwv[e] += p0[e]; cwv[4 + e] += p1[e]; } }
          float za[8], zr[8], xb[8], xk[8];
#pragma unroll
          for (int e = 0; e < 8; ++e) { const float ew = __expf(cwv[e]), ei = frcp(ew), ep = __expf(cwv[e] - lw[e]);
              za[e] = av[e] * ep; zr[e] = r[e] * ew; xb[e] = bv[e] * ei; xk[e] = km[e] * ei;
              if (ptt == 63) WCv[c8 + e] = ew; }
          const int so = swz(ptt, c8);
          { const u32x2 a0 = CVT4(za[0], za[1], za[2], za[3]), a1 = CVT4(za[4], za[5], za[6], za[7]); *(LAS u32x4*)(ZA + so) = (u32x4){a0.x, a0.y, a1.x, a1.y}; }
          { const u32x2 a0 = CVT4(zr[0], zr[1], zr[2], zr[3]), a1 = CVT4(zr[4], zr[5], zr[6], zr[7]); *(LAS u32x4*)(ZR + so) = (u32x4){a0.x, a0.y, a1.x, a1.y}; }
          { const u32x2 a0 = CVT4(xb[0], xb[1], xb[2], xb[3]), a1 = CVT4(xb[4], xb[5], xb[6], xb[7]); *(LAS u32x4*)(XBm + so) = (u32x4){a0.x, a0.y, a1.x, a1.y}; }
          { const u32x2 a0 = CVT4(xk[0], xk[1], xk[2], xk[3]), a1 = CVT4(xk[4], xk[5], xk[6], xk[7]); *(LAS u32x4*)(XK + so) = (u32x4){a0.x, a0.y, a1.x, a1.y}; }
#pragma unroll
          for (int e = 0; e < 8; ++e) { BTt[swz(c8 + e, ptt)] = CVT1(xb[e]); KTt[swz(c8 + e, ptt)] = CVT1(xk[e]); } }
        if (n + 1 < 65) RW_LOAD(n + 1);
        LDS_BAR();
        f32x4 u0[2], cy[2];
        if (wave == 0 || wave == 4) {
            const int bb = wave >> 2, kx = bb << 5, hsel = fq >> 1;
            const FragOff fB[2] = {mkfo(2 * bb, fr, fX), mkfo(2 * bb + 1, fr, fX)};
            const bf16x8 zf = (bf16x8){0, 0, 0, 0, 0, 0, 0, 0};
#define HALF(v, d) ((hsel == (d)) ? (v) : zf)
#define BFR(Mx, e_) (*(const LAS bf16x8*)((Mx) + (fB[e_].o0 ^ kx)))
#define WL_FENCE() asm volatile("s_waitcnt lgkmcnt(0)" ::: "memory")
            f32x4 pt[2];
            {   bf16x8 za[2][2], xb[2][2];
#pragma unroll
                for (int e_ = 0; e_ < 2; ++e_)
#pragma unroll
                    for (int ks = 0; ks < 2; ++ks) { za[e_][ks] = LDF(ZA, fB[e_], ks); xb[e_][ks] = LDF(XBm, fB[e_], ks); }
#pragma unroll
                for (int d = 0; d < 2; ++d) { f32x4 c = (f32x4){0.f, 0.f, 0.f, 0.f};
#pragma unroll
                    for (int ks = 0; ks < 2; ++ks) c = __builtin_amdgcn_mfma_f32_16x16x32_bf16(za[d][ks], xb[d][ks], c, 0, 0, 0);
                    const int s = (2 * bb + d) * 16 + fr, t0 = (2 * bb + d) * 16 + 4 * fq; float m[4];
#pragma unroll
                    for (int r4 = 0; r4 < 4; ++r4) { m[r4] = (s < t0 + r4) ? c[r4] : 0.f; c[r4] = m[r4] + ((s == t0 + r4) ? 1.f : 0.f); }
                    pt[d] = c;
                    *(LAS u32x2*)(MA + swz(s, t0)) = CVT4(m[0], m[1], m[2], m[3]);
#pragma unroll
                    for (int r4 = 0; r4 < 4; ++r4) MAT[swz(t0 + r4, s)] = CVT1(m[r4]);
                    *(LAS u32x2*)(TIv + swz(s, t0)) = CVT4(c[0], c[1], c[2], c[3]); }
                {   f32x4 c = (f32x4){0.f, 0.f, 0.f, 0.f};
#pragma unroll
                    for (int ks = 0; ks < 2; ++ks) c = __builtin_amdgcn_mfma_f32_16x16x32_bf16(za[1][ks], xb[0][ks], c, 0, 0, 0);
                    *(LAS u32x2*)(MA + swz(2 * bb * 16 + fr, (2 * bb + 1) * 16 + 4 * fq)) = CVT4(c[0], c[1], c[2], c[3]); } }
#define INV_SQ(Mc, McT, Mn, MnT) do { _Pragma("unroll") for (int d = 0; d < 2; ++d) { \
                    const f32x4 q_ = __builtin_amdgcn_mfma_f32_16x16x32_bf16(HALF(BFR(Mc, d), d), HALF(BFR(McT, d), d), (f32x4){0.f, 0.f, 0.f, 0.f}, 0, 0, 0);     \
                    const int t_ = (2 * bb + d) * 16 + fr, s0_ = (2 * bb + d) * 16 + 4 * fq; \
                    *(LAS u32x2*)((MnT) + swz(t_, s0_)) = CVT4(q_[0], q_[1], q_[2], q_[3]); \
                    _Pragma("unroll") for (int r4 = 0; r4 < 4; ++r4) (Mn)[swz(s0_ + r4, t_)] = CVT1(q_[r4]); } } while (0)
#define INV_PU(McT, Pc, Pn) do { _Pragma("unroll") for (int d = 0; d < 2; ++d) { \
                    pt[d] = __builtin_amdgcn_mfma_f32_16x16x32_bf16(HALF(BFR(McT, d), d), HALF(BFR(Pc, d), d), pt[d], 0, 0, 0);                                   \
                    *(LAS u32x2*)((Pn) + swz((2 * bb + d) * 16 + fr, (2 * bb + d) * 16 + 4 * fq)) = CVT4(pt[d][0], pt[d][1], pt[d][2], pt[d][3]); } } while (0)
            WL_FENCE(); INV_SQ(MA, MAT, MB, MBT);
            WL_FENCE(); INV_PU(MBT, TIv, PAb); INV_SQ(MB, MBT, MA, MAT);
            WL_FENCE(); INV_PU(MAT, PAb, TIv); INV_SQ(MA, MAT, MB, MBT);
            WL_FENCE(); INV_PU(MBT, TIv, PAb);
#pragma unroll
            for (int d = 0; d < 2; ++d) {
#pragma unroll
                for (int r4 = 0; r4 < 4; ++r4) TIv[swz((2 * bb + d) * 16 + 4 * fq + r4, (2 * bb + d) * 16 + fr)] = CVT1(pt[d][r4]); }
            WL_FENCE();
            {
                const f32x4 c = __builtin_amdgcn_mfma_f32_16x16x32_bf16(HALF(BFR(MA, 0), 1), HALF(BFR(TIv, 1), 1), (f32x4){0.f, 0.f, 0.f, 0.f}, 0, 0, 0);
                *(LAS u32x2*)(PAb + swz((2 * bb + 1) * 16 + fr, 2 * bb * 16 + 4 * fq)) = CVT4(c[0], c[1], c[2], c[3]); }
            WL_FENCE();
            {
                const f32x4 c = __builtin_amdgcn_mfma_f32_16x16x32_bf16(HALF(BFR(PAb, 1), 0), HALF(BFR(PAb, 0), 0), (f32x4){0.f, 0.f, 0.f, 0.f}, 0, 0, 0);
#pragma unroll
                for (int r4 = 0; r4 < 4; ++r4) TIv[swz((2 * bb + 1) * 16 + 4 * fq + r4, 2 * bb * 16 + fr)] = CVT1(c[r4]);
                if (bb == 0) {
                    *(LAS u32x2*)(MBT + swz(fr, 32 + 16 + 4 * fq)) = CVT4(c[0], c[1], c[2], c[3]);
                    *(LAS u32x2*)(MBT + swz(fr, 32 + 4 * fq)) = CVT4(pt[0][0], pt[0][1], pt[0][2], pt[0][3]);
                    *(LAS u32x2*)(MBT + swz(16 + fr, 32 + 16 + 4 * fq)) = CVT4(pt[1][0], pt[1][1], pt[1][2], pt[1][3]);
                    *(LAS u32x2*)(MBT + swz(16 + fr, 32 + 4 * fq)) = (u32x2){0u, 0u}; } }
#undef INV_SQ
#undef INV_PU
#undef WL_FENCE
#undef HALF
#undef BFR
        } else {
            const int wi = wave - 1 - (wave > 4 ? 1 : 0);
            for (int Q = wi; Q < 34; Q += 6) {
                if (Q < 30) { const int mat = Q / 10, q10 = Q - mat * 10, ti = (q10 >= 6) ? 3 : ((q10 >= 3) ? 2 : ((q10 >= 1) ? 1 : 0)), si = q10 - (ti * (ti + 1)) / 2;
                    const LAS bf16_t* Xm = (mat == 1) ? XBm : XK; const LAS bf16_t* Zm = (mat == 0) ? ZA : ZR; LAS bf16_t* Om = (mat == 0) ? MakT : ((mat == 1) ? NbrT : NkrT);
                    f32x4 c = (f32x4){0.f, 0.f, 0.f, 0.f}; const FragOff fS_ = mkfo(si, fr, fX), fT_ = mkfo(ti, fr, fX);
#pragma unroll
                    for (int ks = 0; ks < 2; ++ks) c = __builtin_amdgcn_mfma_f32_16x16x32_bf16(LDF(Xm, fS_, ks), LDF(Zm, fT_, ks), c, 0, 0, 0);
                    const int t = ti * 16 + fr, s0 = si * 16 + 4 * fq; float o[4];
#pragma unroll
                    for (int r4 = 0; r4 < 4; ++r4) { const int s = s0 + r4; const bool keep = (mat == 0) ? (s < t) : (s <= t); o[r4] = keep ? c[r4] : 0.f; }
                    *(LAS u32x2*)(Om + swz(t, s0)) = CVT4(o[0], o[1], o[2], o[3]); }
                else { const int otl = 2 + ((Q - 30) >> 1), osl = (Q - 30) & 1; f32x4 c = (f32x4){0.f, 0.f, 0.f, 0.f}; const FragOff fOT = mkfo(otl, fr, fX), fOS = mkfo(osl, fr, fX);
#pragma unroll
                    for (int ks = 0; ks < 2; ++ks) c = __builtin_amdgcn_mfma_f32_16x16x32_bf16(LDF(ZA, fOT, ks), LDF(XBm, fOS, ks), c, 0, 0, 0);
                    *(LAS u32x2*)(MA + swz(osl * 16 + fr, otl * 16 + 4 * fq)) = CVT4(c[0], c[1], c[2], c[3]); } } }
        LDS_BAR();
#pragma unroll
        for (int u = 0; u < 2; ++u) { f32x4 c = (f32x4){0.f, 0.f, 0.f, 0.f};
#pragma unroll
            for (int ks = 0; ks < 2; ++ks) c = __builtin_amdgcn_mfma_f32_16x16x32_bf16(LDF(ZA, fT[u], ks), LDF(S0b, fI, ks), c, 0, 0, 0);
#pragma unroll
            for (int ks = 0; ks < 2; ++ks) c = __builtin_amdgcn_mfma_f32_16x16x32_bf16(LDF(MakT, fT[u], ks), LDF(VcT, fI, ks), c, 0, 0, 0);
            u0[u] = c; }
#pragma unroll
        for (int u = 0; u < 2; ++u) { f32x4 c = (f32x4){0.f, 0.f, 0.f, 0.f};
#pragma unroll
            for (int ks = 0; ks < 2; ++ks) c = __builtin_amdgcn_mfma_f32_16x16x32_bf16(LDF(S0b, fI, ks), LDF(ZR, fT[u], ks), c, 0, 0, 0);
#pragma unroll
            for (int ks = 0; ks < 2; ++ks) c = __builtin_amdgcn_mfma_f32_16x16x32_bf16(LDF(VcT, fI, ks), LDF(NkrT, fT[u], ks), c, 0, 0, 0);
            cy[u] = c; }
#pragma unroll
        for (int u = 0; u < 2; ++u) {
#pragma unroll
            for (int ks = 0; ks < 2; ++ks) st[u] = __builtin_amdgcn_mfma_f32_16x16x32_bf16(LDF(VcT, fI, ks), LDF(KTt, fT[u], ks), st[u], 0, 0, 0); }
        if (wave < 4) { const int xsl = wave >> 1, xtl = 2 + (wave & 1);
            const f32x4 c = __builtin_amdgcn_mfma_f32_16x16x32_bf16(LDF(MA, mkfo(xsl, fr, fX), 1), LDF(TIv, mkfo(xtl, fr, fX), 1), (f32x4){0.f, 0.f, 0.f, 0.f}, 0, 0, 0);
            *(LAS u32x2*)(MB + swz(xtl * 16 + fr, xsl * 16 + 4 * fq)) = CVT4(c[0], c[1], c[2], c[3]); }
        LDS_BAR();
        if (wave < 4) { const int ntl = 2 + (wave >> 1), nsl = wave & 1;
            const f32x4 c = __builtin_amdgcn_mfma_f32_16x16x32_bf16(LDF(MB, mkfo(ntl, fr, fX), 0), LDF(MBT, mkfo(nsl, fr, fX), 1), (f32x4){0.f, 0.f, 0.f, 0.f}, 0, 0, 0);
#pragma unroll
            for (int r4 = 0; r4 < 4; ++r4) TIv[swz(ntl * 16 + 4 * fq + r4, nsl * 16 + fr)] = CVT1(c[r4]); }
#pragma unroll
        for (int u = 0; u < 2; ++u) *(LAS u32x2*)(U0b + swz(ii * 16 + fr, (tb + u) * 16 + 4 * fq)) = CVT4(u0[u][0], u0[u][1], u0[u][2], u0[u][3]);
        LDS_BAR();
#pragma unroll
        for (int u = 0; u < 2; ++u) { const int ti = tb + u; f32x4 c = (f32x4){0.f, 0.f, 0.f, 0.f};
#pragma unroll
            for (int ks = 0; ks < 2; ++ks) c = __builtin_amdgcn_mfma_f32_16x16x32_bf16(LDF(TIv, fT[u], ks), LDF(U0b, fI, ks), c, 0, 0, 0);
            *(LAS u32x2*)(Ub + swz(ii * 16 + fr, ti * 16 + 4 * fq)) = CVT4(c[0], c[1], c[2], c[3]); }
        LDS_BAR();
        LAS float* YB = CW;
#pragma unroll
        for (int u = 0; u < 2; ++u) { const int ti = tb + u;
#pragma unroll
            for (int ks = 0; ks < 2; ++ks) cy[u] = __builtin_amdgcn_mfma_f32_16x16x32_bf16(LDF(Ub, fI, ks), LDF(NbrT, fT[u], ks), cy[u], 0, 0, 0);
            *(LAS f32x4*)(YB + (ti * 16 + fr) * 64 + ii * 16 + 4 * fq) = cy[u]; }
#pragma unroll
        for (int u = 0; u < 2; ++u) { const int jt = tb + u;
#pragma unroll
            for (int ks = 0; ks < 2; ++ks) st[u] = __builtin_amdgcn_mfma_f32_16x16x32_bf16(LDF(Ub, fI, ks), LDF(BTt, fT[u], ks), st[u], 0, 0, 0);
            st[u] = st[u] * WCv[jt * 16 + fr];
#pragma unroll
            for (int r4 = 0; r4 < 4; ++r4) S0b[swz(ii * 16 + 4 * fq + r4, jt * 16 + fr)] = CVT1(st[u][r4]); }
        LDS_BAR();
        { const f32x4 y0 = *(const LAS f32x4*)(YB + ptt * 64 + c8), y1 = *(const LAS f32x4*)(YB + ptt * 64 + c8 + 4);
          float y[8];
#pragma unroll
          for (int e = 0; e < 4; ++e) { y[e] = y0[e]; y[4 + e] = y1[e]; }
          float sm = 0.f;
#pragma unroll
          for (int e = 0; e < 8; ++e) sm += y[e];
          const float mean = red8(sm) * (1.0f / 64.0f); float sq = 0.f;
#pragma unroll
          for (int e = 0; e < 8; ++e) { y[e] -= mean; sq += y[e] * y[e]; }
          const float rstd = rsqrtf(red8(sq) * (1.0f / 64.0f) + 64e-5f);
          CSTV(lng, 8) CSTV(lnb, 9)
          float o[8];
#pragma unroll
          for (int e = 0; e < 8; ++e) o[e] = (y[e] * rstd * lng[e] + lnb[e] + bonus * v[e]) * g[e];
          if (l >= NMETA && l < L) { const u32x2 a0 = CVT4(o[0], o[1], o[2], o[3]), a1 = CVT4(o[4], o[5], o[6], o[7]);
              *(u32x4*)(A12 + ((size_t)b * SEQ + (l - NMETA)) * 2048 + 1024 + col) = (u32x4){a0.x, a0.y, a1.x, a1.y}; } }
    }
    __syncthreads();
#undef LDS_BAR
#undef CVT1
#undef CVT4
#undef CSTV
#undef RW_LOAD

}

__device__ __forceinline__ void gla_item(const Args& a, LAS unsigned char* lds, int item) {
    const int tid0 = tidx(), wave = __builtin_amdgcn_readfirstlane(tid0 >> 6);
    const int b = item >> 4, h = (item >> 2) & 3, s = item & 3;
    LAS float* BL0 = (LAS float*)lds;
    LAS bf16_t* QT = (LAS bf16_t*)(BL0 + 128);
    LAS bf16_t* KT = QT + 8192;
    LAS bf16_t* QS0 = KT + 8192;
    LAS bf16_t* KDT = QS0 + 16384;
    LAS bf16_t* VT0 = KDT + 8192;
    LAS bf16_t* AM = VT0 + 8192;
    LAS bf16_t* STB0 = AM + 4096;
    bf16_t* P = (bf16_t*)(a.ws + WS_P);
    for (int i = tid0; i < 4096; i += 512) ((LAS unsigned*)STB0)[i] = 0u;
    const int lane0 = tid0 & 63, fr0 = lane0 & 15, fq0 = lane0 >> 4;
    bf16x8 w2f;
    { unsigned wv_[4] = {0u, 0u, 0u, 0u};
      if (fq0 < 2) {
#pragma unroll
          for (int j = 0; j < 4; ++j) wv_[j] = pk2(a.in[4][(8 * fq0 + 2 * j) * 512 + h * 128 + 16 * wave + fr0], a.in[4][(8 * fq0 + 2 * j + 1) * 512 + h * 128 + 16 * wave + fr0]); }
      w2f = __builtin_bit_cast(bf16x8, (u32x4){wv_[0], wv_[1], wv_[2], wv_[3]}); }
    const f32x4 b2v = *(const f32x4*)(a.in[5] + h * 128 + 16 * wave + 4 * fq0);
    f32x4 st[4];
#pragma unroll
    for (int dt = 0; dt < 4; ++dt) st[dt] = (f32x4){0.f, 0.f, 0.f, 0.f};
    const float qscale = 0.08838834764831845f;
    const u32x4 z4 = (u32x4){0u, 0u, 0u, 0u}; const u32x2 z2 = (u32x2){0u, 0u};
    u32x4 La[4], Lv; u32x2 Lq[4], Lk[4];
#define GL_LOAD(nn) do { Lv = z4; \
        _Pragma("unroll") for (int ti_ = 0; ti_ < 4; ++ti_) { const int l_ = (nn) * 64 - 48 + 16 * ti_ + fr0; La[ti_] = z4; Lq[ti_] = z2; Lk[ti_] = z2; \
            if (l_ >= 0) { const bf16_t* pr_ = P + (size_t)prow(b, l_) * LDP; if (fq0 < 2) La[ti_] = *(const u32x4*)(pr_ + C_GA + 8 * fq0); \
                Lq[ti_] = *(const u32x2*)(pr_ + C_GQ + h * 128 + 16 * wave + 4 * fq0); Lk[ti_] = *(const u32x2*)(pr_ + C_GK + h * 128 + 16 * wave + 4 * fq0); } } \
        { const int l_ = (nn) * 64 - 48 + (tid0 >> 3); if (l_ >= 0) Lv = *(const u32x4*)(P + (size_t)prow(b, l_) * LDP + C_GV + h * 256 + s * 64 + (tid0 & 7) * 8); } } while (0)
#define GL_BAR() do { asm volatile("s_waitcnt lgkmcnt(0)" ::: "memory"); __builtin_amdgcn_s_barrier(); asm volatile("" ::: "memory"); } while (0)
    GL_LOAD(0);
    __syncthreads();
    for (int n = 0; n < 65; ++n) {
        int tid = tid0; asm volatile("" : "+v"(tid));
        const int lane = tid & 63, fr = lane & 15, fq = lane >> 4, tl = tid >> 3;
        const int fX = (fq ^ (fr >> 1)) & 7; const FragOff fTi = mkfo(wave >> 1, fr, fX); const FragOff fJ[2] = {mkfo(2 * (wave & 1), fr, fX), mkfo(2 * (wave & 1) + 1, fr, fX)}; const FragOff fW = mkfo(wave, fr, fX);
        const int l0 = n * 64 - 48;
        LAS float* BL = BL0; LAS bf16_t* QS = QS0 + (n & 1) * 8192; LAS bf16_t* VT = VT0 + (n & 1) * 4096; LAS bf16_t* STBr = STB0 + (n & 1) * 8192; LAS bf16_t* STBw = STB0 + ((n + 1) & 1) * 8192;
        { f32x4 bt[4];
#pragma unroll
          for (int ti = 0; ti < 4; ++ti) { const bool valid = (l0 + 16 * ti + fr) >= 0;
              f32x4 x = __builtin_amdgcn_mfma_f32_16x16x32_bf16(w2f, __builtin_bit_cast(bf16x8, La[ti]), (f32x4){0.f, 0.f, 0.f, 0.f}, 0, 0, 0);
#pragma unroll
              for (int r = 0; r < 4; ++r) { const float xx = x[r] + b2v[r]; float gk = valid ? (fminf(xx, 0.f) - __logf(1.0f + __expf(-fabsf(xx)))) * (1.0f / 16.0f) : 0.f;
                  gk += dppf<0x111>(gk); gk += dppf<0x112>(gk); gk += dppf<0x114>(gk); gk += dppf<0x118>(gk);
                  x[r] = gk; }
              bt[ti] = x; }
          f32x4 bref, blast;
          { f32x4 run = (f32x4){0.f, 0.f, 0.f, 0.f};
#pragma unroll
            for (int ti = 0; ti < 4; ++ti) { f32x4 tot;
#pragma unroll
                for (int r = 0; r < 4; ++r) tot[r] = __shfl(bt[ti][r], 15, 16);
                bt[ti] = bt[ti] + run; run = run + tot; if (ti == 1) bref = run; }
            blast = run; }
          if (fr == 0) *(LAS f32x4*)(BL + 16 * wave + 4 * fq) = (f32x4){__expf(blast[0]), __expf(blast[1]), __expf(blast[2]), __expf(blast[3])};
          const int hf = wave >> 2, cq = (16 * wave + 4 * fq) & 63;
#pragma unroll
          for (int ti = 0; ti < 4; ++ti) { const int tt = 16 * ti + fr;
              const float qv[4] = {bf_lo(Lq[ti].x), bf_hi(Lq[ti].x), bf_lo(Lq[ti].y), bf_hi(Lq[ti].y)}, kv[4] = {bf_lo(Lk[ti].x), bf_hi(Lk[ti].x), bf_lo(Lk[ti].y), bf_hi(Lk[ti].y)};
              float qt[4], kt[4], qs[4];
#pragma unroll
              for (int r = 0; r < 4; ++r) { const float bb = bt[ti][r];
                  const float e1 = __expf(bb - bref[r]), e2 = __builtin_amdgcn_rcpf(e1), e3 = __expf(bb), e4 = __expf(blast[r] - bb);
                  qt[r] = qv[r] * qscale * e1; kt[r] = kv[r] * e2; qs[r] = qv[r] * qscale * e3;
                  KDT[swz(16 * wave + 4 * fq + r, tt)] = (bf16_t)f2bf(kv[r] * e4); }
              const int so = hf * 4096 + swz(tt, cq);
              *(LAS u32x2*)(QT + so) = (u32x2){pk2(qt[0], qt[1]), pk2(qt[2], qt[3])};
              *(LAS u32x2*)(KT + so) = (u32x2){pk2(kt[0], kt[1]), pk2(kt[2], kt[3])};
              *(LAS u32x2*)(QS + so) = (u32x2){pk2(qs[0], qs[1]), pk2(qs[2], qs[3])}; }
          const unsigned wv[4] = {Lv.x, Lv.y, Lv.z, Lv.w}; const int d8 = (tid & 7) * 8;
#pragma unroll
          for (int j = 0; j < 4; ++j) { VT[swz(d8 + 2 * j, tl)] = (bf16_t)(wv[j] & 0xffffu); VT[swz(d8 + 2 * j + 1, tl)] = (bf16_t)(wv[j] >> 16); } }
        if (n + 1 < 65) GL_LOAD(n + 1);
        GL_BAR();
        { const int ti = wave >> 1;
#pragma unroll
          for (int jj = 0; jj < 2; ++jj) { const int ji = 2 * (wave & 1) + jj; f32x4 c = (f32x4){0.f, 0.f, 0.f, 0.f};
              if (ji <= ti) {
#pragma unroll
                  for (int ks = 0; ks < 4; ++ks) c = __builtin_amdgcn_mfma_f32_16x16x32_bf16(LDF2(KT, fJ[jj], ks), LDF2(QT, fTi, ks), c, 0, 0, 0); }
              const int t = ti * 16 + fr, j0 = ji * 16 + 4 * fq;
              float o[4];
#pragma unroll
              for (int r = 0; r < 4; ++r) o[r] = (j0 + r <= t) ? c[r] : 0.f;
              *(LAS u32x2*)(AM + swz(t, j0)) = (u32x2){pk2(o[0], o[1]), pk2(o[2], o[3])}; } }
        GL_BAR();
        { const int ti = wave >> 1, l0t = l0 + ti * 16 + fr;
#pragma unroll
          for (int dd = 0; dd < 2; ++dd) { const int di = 2 * (wave & 1) + dd; f32x4 c = (f32x4){0.f, 0.f, 0.f, 0.f};
#pragma unroll
              for (int ks = 0; ks < 2; ++ks) c = __builtin_amdgcn_mfma_f32_16x16x32_bf16(LDF(VT, fJ[dd], ks), LDF(AM, fTi, ks), c, 0, 0, 0);
#pragma unroll
              for (int ks = 0; ks < 4; ++ks) c = __builtin_amdgcn_mfma_f32_16x16x32_bf16(LDF2(STBr, fJ[dd], ks), LDF2(QS, fTi, ks), c, 0, 0, 0);
              if (l0t >= NMETA && !(a.flags & 8)) *(u32x2*)(P + ((size_t)b * SEQ + (l0t - NMETA)) * LDP + C_GV + h * 256 + s * 64 + di * 16 + 4 * fq) = (u32x2){pk2(c[0], c[1]), pk2(c[2], c[3])}; } }
        { const f32x4 dec = *(const LAS f32x4*)(BL + wave * 16 + 4 * fq);
          bf16x8 af[2];
#pragma unroll
          for (int ks = 0; ks < 2; ++ks) af[ks] = LDF(KDT, fW, ks);
#pragma unroll
          for (int dt = 0; dt < 4; ++dt) { st[dt] = st[dt] * dec;
#pragma unroll
              for (int ks = 0; ks < 2; ++ks) st[dt] = __builtin_amdgcn_mfma_f32_16x16x32_bf16(af[ks], LDF(VT, mkfo(dt, fr, fX), ks), st[dt], 0, 0, 0);
              const int dk0 = wave * 16 + 4 * fq;
              *(LAS u32x2*)(STBw + (dk0 >> 6) * 4096 + swz(dt * 16 + fr, dk0 & 63)) = (u32x2){pk2(st[dt][0], st[dt][1]), pk2(st[dt][2], st[dt][3])}; } }
    }
    __syncthreads();
#undef GL_LOAD
#undef GL_BAR
}

__device__ __forceinline__ void phase_glanorm(const Args& a) {
    const int tid_ = tidx(), wave = tid_ >> 6, lane = tid_ & 63;
    const bf16_t* P = (const bf16_t*)(a.ws + WS_P); bf16_t* A12 = (bf16_t*)(a.ws + WS_R5);
    const int c0 = lane * 16;
    float gn[16];
#pragma unroll
    for (int j = 0; j < 16; ++j) gn[j] = a.in[6][(c0 & 255) + j];
    const int row_first = blockIdx.x * 8 + wave, row_step = gridDim.x * 8;
    u32x4 q[4], nq[4];
    { const bf16_t* pr = P + (size_t)(row_first < TR ? row_first : 0) * LDP; q[0] = *(const u32x4*)(pr + C_GV + c0); q[1] = *(const u32x4*)(pr + C_GV + c0 + 8); q[2] = *(const u32x4*)(pr + C_GR + c0); q[3] = *(const u32x4*)(pr + C_GR + c0 + 8);
#pragma unroll
      for (int j = 0; j < 4; ++j) nq[j] = q[j]; }
    for (int row = row_first; row < TR; row += row_step) {
        if (row + row_step < TR) { const bf16_t* pr = P + (size_t)(row + row_step) * LDP; nq[0] = *(const u32x4*)(pr + C_GV + c0); nq[1] = *(const u32x4*)(pr + C_GV + c0 + 8); nq[2] = *(const u32x4*)(pr + C_GR + c0); nq[3] = *(const u32x4*)(pr + C_GR + c0 + 8); }
        const u32x4 o0 = q[0], o1 = q[1], r0 = q[2], r1 = q[3];
#pragma unroll
        for (int j = 0; j < 4; ++j) q[j] = nq[j];
        const unsigned ow[8] = {o0.x, o0.y, o0.z, o0.w, o1.x, o1.y, o1.z, o1.w}, rw[8] = {r0.x, r0.y, r0.z, r0.w, r1.x, r1.y, r1.z, r1.w};
        float o[16], r[16]; float ss = 0.f;
#pragma unroll
        for (int j = 0; j < 8; ++j) { o[2 * j] = bf_lo(ow[j]); o[2 * j + 1] = bf_hi(ow[j]); r[2 * j] = bf_lo(rw[j]); r[2 * j + 1] = bf_hi(rw[j]); ss += o[2 * j] * o[2 * j] + o[2 * j + 1] * o[2 * j + 1]; }
        const float rstd = rsqrtf(red16(ss) * (1.0f / 256.0f) + EPS);
        float y[16];
#pragma unroll
        for (int j = 0; j < 16; ++j) y[j] = o[j] * rstd * gn[j] * (r[j] * sigmoidf_(r[j]));
        bf16_t* dst = A12 + (size_t)row * 2048 + c0;
        *(u32x4*)dst = (u32x4){pk2(y[0], y[1]), pk2(y[2], y[3]), pk2(y[4], y[5]), pk2(y[6], y[7])};
        *(u32x4*)(dst + 8) = (u32x4){pk2(y[8], y[9]), pk2(y[10], y[11]), pk2(y[12], y[13]), pk2(y[14], y[15])};
    }
}

__device__ __forceinline__ void phase_router(const Args& a, LAS unsigned char* lds) {
    const int tid = tidx(), wave = tid >> 6, lane = tid & 63, fr = lane & 15, fq = lane >> 4;
    constexpr int WPITCH = 2064;
    LAS int* HIST = (LAS int*)(lds + 64 * WPITCH);
    const float* gf = a.in[26]; const float* brt = a.in[28];
    const bf16_t* h2 = (const bf16_t*)(a.ws + WS_R5); bf16_t* U2 = (bf16_t*)(a.ws + WS_U2);
    int* tope = (int*)(a.ws + WS_TOPE); float* topc = (float*)(a.ws + WS_TOPC); int* cnt = (int*)(a.ws + WS_CNT);
    { const u32x4* src = (const u32x4*)(a.ws + WS_WRS);
      for (int i = tid; i < 64 * 128; i += 512) *(LAS u32x4*)(lds + (i >> 7) * WPITCH + (i & 127) * 16) = src[i]; }
    if (tid < 32) HIST[tid] = 0;
    __syncthreads();
    const int G = gridDim.x, RPB = (TR + G - 1) / G;
    const int r0 = blockIdx.x * RPB, r1 = (r0 + RPB < TR) ? (r0 + RPB) : TR;
    float bias[8];
#pragma unroll
    for (int j = 0; j < 8; ++j) bias[j] = brt[(j >> 2) * 16 + 4 * fq + (j & 3)];
    for (int rg = r0 + wave * 16; rg < r1; rg += 128) {
        const int row = rg + fr; const bool ok = row < r1;
        const u32x4* hp = (const u32x4*)(h2 + (size_t)(ok ? row : r0) * D) + fq;
        u32x4 hv[32];
#pragma unroll
        for (int s = 0; s < 32; ++s) hv[s] = hp[s * 4];
        float ss = 0.f;
#pragma unroll
        for (int s = 0; s < 32; ++s)
#pragma unroll
            for (int c = 0; c < 4; ++c) { const float lo = bf_lo(hv[s][c]), hi = bf_hi(hv[s][c]); ss += lo * lo; ss += hi * hi; }
        ss += __shfl_xor(ss, 16); ss += __shfl_xor(ss, 32);
        const float rs = rsqrtf(ss * (1.0f / D) + EPS);
#pragma unroll
        for (int s = 0; s < 32; ++s) asm volatile("" : "+v"(hv[s]));
        f32x4 acc0 = (f32x4){0.f, 0.f, 0.f, 0.f}, acc1 = acc0;
        const LAS unsigned char* wp = lds + fr * WPITCH + fq * 16;
#pragma unroll
        for (int s = 0; s < 32; ++s) {
            const bf16x8 tk = __builtin_bit_cast(bf16x8, hv[s]);
            const bf16x8 w0h = *(const LAS bf16x8*)(wp + s * 64), w1h = *(const LAS bf16x8*)(wp + 16 * WPITCH + s * 64);
            const bf16x8 w0l = *(const LAS bf16x8*)(wp + 32 * WPITCH + s * 64), w1l = *(const LAS bf16x8*)(wp + 48 * WPITCH + s * 64);
            acc0 = __builtin_amdgcn_mfma_f32_16x16x32_bf16(w0h, tk, acc0, 0, 0, 0); acc1 = __builtin_amdgcn_mfma_f32_16x16x32_bf16(w1h, tk, acc1, 0, 0, 0);
            acc0 = __builtin_amdgcn_mfma_f32_16x16x32_bf16(w0l, tk, acc0, 0, 0, 0); acc1 = __builtin_amdgcn_mfma_f32_16x16x32_bf16(w1l, tk, acc1, 0, 0, 0);
            if ((s & 3) == 3) asm volatile("" : "+v"(acc0), "+v"(acc1) :: "memory");
        }
#pragma unroll
        for (int s = 0; s < 32; ++s) asm volatile("" : "+v"(hv[s]));
        { u32x4* up = (u32x4*)(U2 + (size_t)row * D) + fq;
#pragma unroll
          for (int s = 0; s < 32; ++s) { u32x4 w;
#pragma unroll
              for (int c = 0; c < 4; ++c) w[c] = pk2(bf_lo(hv[s][c]) * rs, bf_hi(hv[s][c]) * rs);
              if (ok) up[s * 4] = w; } }
        float v[8];
#pragma unroll
        for (int j = 0; j < 4; ++j) { v[j] = acc0[j] * rs + bias[j]; v[4 + j] = acc1[j] * rs + bias[4 + j]; }
        int ti[4]; float tv[4];
#pragma unroll
        for (int kk = 0; kk < 4; ++kk) { float bv = v[0]; int be = 4 * fq;
#pragma unroll
            for (int j = 1; j < 8; ++j) { const int ej = (j >> 2) * 16 + 4 * fq + (j & 3); if (v[j] > bv) { bv = v[j]; be = ej; } }
#pragma unroll
            for (int o = 16; o < 64; o <<= 1) { const float ov = __shfl_xor(bv, o); const int oe = __shfl_xor(be, o); const bool g = (ov > bv) || (ov == bv && oe < be); bv = g ? ov : bv; be = g ? oe : be; }
            ti[kk] = be; tv[kk] = bv;
#pragma unroll
            for (int j = 0; j < 8; ++j) { const int ej = (j >> 2) * 16 + 4 * fq + (j & 3); v[j] = (ej == be) ? -3.0e38f : v[j]; } }
        if (fq == 0 && ok) {
            const float e1 = __expf(tv[1] - tv[0]), e2 = __expf(tv[2] - tv[0]), e3 = __expf(tv[3] - tv[0]); const float inv = 1.0f / (1.0f + e1 + e2 + e3);
            *(int4*)(tope + (size_t)row * 4) = make_int4(ti[0], ti[1], ti[2], ti[3]);
            *(float4*)(topc + (size_t)row * 4) = make_float4(inv, e1 * inv, e2 * inv, e3 * inv);
#pragma unroll
            for (int kk = 0; kk < 4; ++kk) __hip_atomic_fetch_add(HIST + ti[kk], 1, __ATOMIC_RELAXED, __HIP_MEMORY_SCOPE_WORKGROUP);
        }
    }
    __syncthreads();
    if (tid < 32) cnt[blockIdx.x * 32 + tid] = HIST[tid];
    __syncthreads();
    const int gw = blockIdx.x * 8 + wave, NGW = gridDim.x * 8;
    constexpr int J_GU = 16 * 64;
    for (int job = gw + a.ntail * J_GU; job < NE * J_GU; job += NGW) { const int e = job / J_GU, r = job % J_GU;
        tr_item<2>(a.in[29] + (size_t)e * 1024 * 2048, 2048, 1024, (bf16_t*)a.out + (size_t)e * 2048 * 1024, 1024, (r % 16) * 64, (r / 16) * 32, gf, lane); }
}

__device__ __forceinline__ void convert_early(const Args& a, int cw, int ncw) {
    const int tid = tidx(), wave = tid >> 6, lane = tid & 63;
    const int gw = cw * 8 + wave, NGW = ncw * 8;
    constexpr int J_GU = 16 * 64, J_DN = 16 * 32;
    const int NJ = NE * J_DN + a.ntail * J_GU;
    for (int job = gw; job < NJ; job += NGW) {
        if (job < NE * J_DN) { const int e = job / J_DN, r = job % J_DN;
            tr_item<0>(a.in[31] + (size_t)e * 1024 * 1024, 1024, 1024, (bf16_t*)(a.ws + WS_WDN) + (size_t)e * 1024 * 1024, 1024, (r % 16) * 64, (r / 16) * 32, nullptr, lane); }
        else { const int j2 = job - NE * J_DN, e = j2 / J_GU, r = j2 % J_GU;
            tr_item<2>(a.in[29] + (size_t)e * 1024 * 2048, 2048, 1024, (bf16_t*)a.out + (size_t)e * 2048 * 1024, 1024, (r % 16) * 64, (r / 16) * 32, a.in[26], lane); }
    }
}

__device__ __forceinline__ void phase_positions(const Args& a, LAS unsigned char* lds) {
    const int tid = tidx();
    LAS int* PB = (LAS int*)lds;
    LAS int* PTt = PB + 512;
    LAS int* BASE = PTt + 512;
    LAS int* TOT = BASE + 32;
    LAS int* PST = TOT + 32;
    LAS int* ENT = PST + 64;
    LAS int* RNK = ENT + 8192;
    LAS int* WC = RNK + 8192;
    const int* cnt = (const int*)(a.ws + WS_CNT); const int* tope = (const int*)(a.ws + WS_TOPE); const float* topc = (const float*)(a.ws + WS_TOPC);
    int* pos = (int*)(a.ws + WS_POS); int* tok = (int*)(a.ws + WS_TOK); float* cw = (float*)(a.ws + WS_CW); int* misc = (int*)(a.ws + WS_MISC);
    const int G = gridDim.x, RPB = (TR + G - 1) / G;
    { const int e = tid & 31, part = tid >> 5; int sb = 0, st = 0;
      for (int bb = part; bb < G; bb += 16) { const int c = cnt[bb * 32 + e]; st += c; if (bb < (int)blockIdx.x) sb += c; }
      PB[part * 32 + e] = sb; PTt[part * 32 + e] = st; }
    __syncthreads();
    if (tid < 32) { int sb = 0, st = 0;
#pragma unroll
        for (int p = 0; p < 16; ++p) { sb += PB[p * 32 + tid]; st += PTt[p * 32 + tid]; }
        BASE[tid] = sb; TOT[tid] = st; }
    __syncthreads();
    if (tid == 0) { int acc = 0; for (int e = 0; e < 32; ++e) { PST[e] = acc * 256; acc += (TOT[e] + 255) >> 8; } PST[32] = acc * 256; }
    __syncthreads();
    const int r0 = blockIdx.x * RPB, r1 = (r0 + RPB < TR) ? (r0 + RPB) : TR;
    const int nent = (r1 > r0) ? (r1 - r0) * 4 : 0;
    for (int i = tid; i < nent; i += 512) ENT[i] = tope[(size_t)r0 * 4 + i];
    __syncthreads();
    const int nchunk = (nent + 63) >> 6;
    for (int c = tid >> 6; c < nchunk; c += 8) { const int lane = tid & 63, i = c * 64 + lane; const int e = (i < nent) ? ENT[i] : -1; int myrank = 0;
        for (int q = 0; q < 32; ++q) { const unsigned long long m = __ballot(e == q); if (e == q) myrank = __popcll(m & ((1ull << lane) - 1ull)); if (lane == q) WC[c * 32 + q] = __popcll(m); }
        if (i < nent) RNK[i] = myrank; }
    __syncthreads();
    if (tid < 32) { int acc = 0; for (int c = 0; c < nchunk; ++c) { const int t = WC[c * 32 + tid]; WC[c * 32 + tid] = acc; acc += t; } }
    __syncthreads();
    for (int i = tid; i < nent; i += 512) { const int e = ENT[i], p = PST[e] + BASE[e] + WC[(i >> 6) * 32 + e] + RNK[i]; pos[(size_t)r0 * 4 + i] = p; tok[p] = r0 + (i >> 2); cw[p] = topc[(size_t)r0 * 4 + i]; }
    for (int e = blockIdx.x; e < 32; e += G) for (int p = PST[e] + TOT[e] + tid; p < PST[e + 1]; p += 512) { tok[p] = 0; cw[p] = 0.f; }
    if (blockIdx.x == 0) { const int MT = PST[32] >> 8;
        for (int m = tid; m < MT; m += 512) { int e = 0;
            for (int q = 1; q < 32; ++q) e = (PST[q] <= m * 256) ? q : e;
            misc[1 + m] = e; }
        if (tid == 0) misc[0] = MT; }
}

__device__ __forceinline__ void phase_final(const Args& a) {
    const int tid_ = tidx(), wave = tid_ >> 6, lane = tid_ & 63;
    const bf16_t* h2 = (const bf16_t*)(a.ws + WS_R5); const bf16_t* YS = (const bf16_t*)(a.ws + WS_YS); const int* pos = (const int*)(a.ws + WS_POS);
    const float* gfin = a.in[33];
    f32x4 g4[4];
#pragma unroll
    for (int j = 0; j < 4; ++j) g4[j] = ((const f32x4*)gfin)[lane + 64 * j];
    const int row_first = blockIdx.x * 8 + wave, row_step = gridDim.x * 8;
#define FIN_LOAD(H, Y, r_, p_) do { _Pragma("unroll") for (int j = 0; j < 4; ++j) { H[j] = ((const u32x2*)(h2 + (size_t)(r_) * D))[lane + 64 * j]; \
        Y[0][j] = ((const u32x2*)(YS + (size_t)(p_).x * D))[lane + 64 * j]; Y[1][j] = ((const u32x2*)(YS + (size_t)(p_).y * D))[lane + 64 * j]; \
        Y[2][j] = ((const u32x2*)(YS + (size_t)(p_).z * D))[lane + 64 * j]; Y[3][j] = ((const u32x2*)(YS + (size_t)(p_).w * D))[lane + 64 * j]; } } while (0)
    u32x2 hc[4], yc[4][4], hn[4], yn[4][4];
    int4 pn = make_int4(0, 0, 0, 0);
    if (row_first < TR) { const int4 pc = *(const int4*)(pos + (size_t)row_first * 4); FIN_LOAD(hc, yc, row_first, pc); }
    if (row_first + row_step < TR) pn = *(const int4*)(pos + (size_t)(row_first + row_step) * 4);
    for (int row = row_first; row < TR; row += row_step) {
        const int nrow = row + row_step, nnrow = nrow + row_step;
        int4 pnn = pn;
        if (nrow < TR) FIN_LOAD(hn, yn, nrow, pn);
        if (nnrow < TR) pnn = *(const int4*)(pos + (size_t)nnrow * 4);
        f32x4 v[4]; float ss = 0.f;
#pragma unroll
        for (int j = 0; j < 4; ++j) { v[j] = (f32x4){bf_lo(hc[j].x), bf_hi(hc[j].x), bf_lo(hc[j].y), bf_hi(hc[j].y)};
#pragma unroll
            for (int k = 0; k < 4; ++k) { const u32x2 w = yc[k][j]; v[j].x += bf_lo(w.x); v[j].y += bf_hi(w.x); v[j].z += bf_lo(w.y); v[j].w += bf_hi(w.y); }
            ss += (v[j].x * v[j].x + v[j].y * v[j].y) + (v[j].z * v[j].z + v[j].w * v[j].w); }
        const float rstd = rsqrtf(wave_sum(ss) * (1.0f / D) + EPS);
        f32x4* o = (f32x4*)(a.out + (size_t)row * D);
#pragma unroll
        for (int j = 0; j < 4; ++j) o[lane + 64 * j] = v[j] * rstd * g4[j];
#pragma unroll
        for (int j = 0; j < 4; ++j) { hc[j] = hn[j];
#pragma unroll
            for (int k = 0; k < 4; ++k) yc[k][j] = yn[k][j]; }
        pn = pnn;
    }
#undef FIN_LOAD
}

__global__ void __launch_bounds__(512, 2) fwd(Args args) {
    extern __shared__ __attribute__((aligned(16))) unsigned char smem[];
    LAS unsigned char* lds = (LAS unsigned char*)smem;
    const int lo = args.ph_lo, hi = args.ph_hi, G = gridDim.x;
    volatile LAS unsigned* MISC = (volatile LAS unsigned*)(lds + LDS_MISC);
    if (threadIdx.x < 4) MISC[threadIdx.x] = 0u;
    __syncthreads();
    XcdBarrier bar; bar.bar = (unsigned*)(args.ws + WS_BAR); bar.x = 0; bar.st = MISC;
    if (hi - lo > 1) bar = xcd_barrier_post((unsigned*)(args.ws + WS_BAR), MISC);
#define IN(k) (lo <= (k) && (k) < hi)
#define SEAM(k) do { if (IN(k) && IN((k) + 1)) xcd_barrier(bar); } while (0)
    unsigned char* ws = args.ws;
    if (IN(0)) { phase_prologue(args, lds); } SEAM(0);
    if (IN(1)) {
        pg8::ProbDense S; S.A = (const bf16_t*)(ws + WS_XB); S.lda = D; S.Bt = (const bf16_t*)(ws + WS_WIN); S.ldb = 1024; S.so.init(TR / 256, LDP / 256, G, (int)blockIdx.x, MK_WGM_INPROJ);
        pg8::EpiBf16 E{(bf16_t*)(ws + WS_P), LDP};
        pg8::gemm_phase<pg8::EpiBf16, pg8::ProbDense, 1024>(lds, S, E);
    } SEAM(1);
    if (IN(2)) { phase_lora(args, lds); } SEAM(2);
    if (IN(3)) { for (int it = blockIdx.x; it < 256; it += G) { if (it < 128) { if (!(args.flags & 2)) rwkv_item(args, lds, it); } else { if (!(args.flags & 1)) gla_item(args, lds, it - 128); } __syncthreads(); }
                 if ((int)blockIdx.x >= G / 2 && !(args.flags & 16)) convert_early(args, (int)blockIdx.x - G / 2, G - G / 2); } SEAM(3);
    if (IN(4)) { phase_glanorm(args); } SEAM(4);
    if (IN(5)) {
        pg8::ProbMix S; S.A = (const bf16_t*)(ws + WS_R5); S.Bt = (const bf16_t*)(ws + WS_WGR); S.so.init(TR / 256, 4, G, (int)blockIdx.x);
        pg8::EpiMix E{(const bf16_t*)(ws + WS_P), (bf16_t*)(ws + WS_MIX)};
        pg8::gemm_phase<pg8::EpiMix, pg8::ProbMix, 1024>(lds, S, E);
    } SEAM(5);
    if (IN(6)) {
        pg8::ProbDense S; S.A = (const bf16_t*)(ws + WS_MIX); S.lda = D; S.Bt = (const bf16_t*)(ws + WS_WOUT); S.ldb = 1024; S.so.init(TR / 256, 4, G, (int)blockIdx.x);
        pg8::EpiH2 E{args.in[0], (bf16_t*)(ws + WS_R5)};
        pg8::gemm_phase<pg8::EpiH2, pg8::ProbDense, 1024>(lds, S, E);
    } SEAM(6);
    if (IN(7)) { phase_router(args, lds); } SEAM(7);
    if (IN(8)) { phase_positions(args, lds); } SEAM(8);
    if (IN(9)) {
        const int* misc = (const int*)(ws + WS_MISC); const int MT = __builtin_amdgcn_readfirstlane(misc[0]);
        pg8::ProbMoE S; S.A = (const bf16_t*)(ws + WS_U2); S.tok = (const int*)(ws + WS_TOK); S.Bt = (const bf16_t*)args.out; S.Bt2 = S.Bt; S.ntail = 0; S.nN = 8; S.tile2e = misc + 1; S.so.init(MT, 8, G, (int)blockIdx.x, MK_WGM_MOE);
        S.rdy = nullptr; S.need = 0u; S.mask = 0u;
        pg8::EpiSwiglu E{args.in[30], (bf16_t*)(ws + WS_ACT), (unsigned*)(ws + WS_BAR) + XB_RDY};
        pg8::gemm_phase<pg8::EpiSwiglu, pg8::ProbMoE, 1024>(lds, S, E);
    }
    __syncthreads();
    if (IN(10)) {
        const int* misc = (const int*)(ws + WS_MISC); const int MT = __builtin_amdgcn_readfirstlane(misc[0]);
        const int cs = (((int)blockIdx.x - (MT * 8) % G) % G + G) % G;
        pg8::ProbMoE S; S.A = (const bf16_t*)(ws + WS_ACT); S.tok = nullptr; S.Bt = (const bf16_t*)(ws + WS_WDN); S.Bt2 = S.Bt; S.ntail = 0; S.nN = 4; S.tile2e = misc + 1; S.so.init(MT, 4, G, cs, MK_WGM_MOE);
        S.rdy = (unsigned*)(ws + WS_BAR) + XB_RDY; S.need = 64u;
        {
            const int t_ = tidx();
            if (t_ < 64) { pg8::Unit u_; unsigned ok = 1u;
                if (t_ < 32 && S.so.next(t_, u_)) ok = (xb_ld(S.rdy + u_.pm) >= S.need) ? 1u : 0u;
                const unsigned long long bal = __ballot(ok != 0u);
                __builtin_amdgcn_fence(__ATOMIC_ACQUIRE, "agent");
                asm volatile("s_waitcnt vmcnt(0)" ::: "memory");
                if (t_ == 0) MISC[16] = (unsigned)bal; }
            __syncthreads();
            S.mask = (unsigned)__builtin_amdgcn_readfirstlane((int)MISC[16]); }
        pg8::EpiDown E{args.in[32], (const float*)(ws + WS_CW), (bf16_t*)(ws + WS_YS)};
        pg8::gemm_phase<pg8::EpiDown, pg8::ProbMoE, 1024>(lds, S, E);
    } SEAM(10);
    if (IN(11)) { phase_final(args); }
#undef IN
#undef SEAM
}
}

extern "C" void kernel_launch(void* const* d_in, const int* in_sizes, int n_in, void* d_out, int out_size, void* d_ws, size_t ws_size, hipStream_t stream) {
    static int grid = 0;
    if (grid == 0) {
        if (n_in != 34 || ws_size < mk::WS_END) { fprintf(stderr, "kernel_launch: expected 34 inputs and >= %zu bytes of workspace (got %d, %zu)\n", (size_t)mk::WS_END, n_in, ws_size); grid = -1; return; }
        int dev = 0, cus = 0;
        if (hipGetDevice(&dev) != hipSuccess || hipDeviceGetAttribute(&cus, hipDeviceAttributeMultiprocessorCount, dev) != hipSuccess) { grid = -1; return; }
        if (hipFuncSetAttribute((const void*)mk::fwd, hipFuncAttributeMaxDynamicSharedMemorySize, mk::LDS_BYTES) != hipSuccess) { fprintf(stderr, "kernel_launch: hipFuncSetAttribute failed\n"); grid = -1; return; }
        int per_cu = 0;
        if (hipOccupancyMaxActiveBlocksPerMultiprocessor(&per_cu, (const void*)mk::fwd, 512, mk::LDS_BYTES) != hipSuccess || per_cu < 1) { fprintf(stderr, "kernel_launch: occupancy query says %d blocks per CU\n", per_cu); }
        (void)hipGetLastError();
        grid = cus > 0 ? cus : 256;
    }
    if (grid < 0) return;
    (void)hipMemsetAsync((char*)d_ws + mk::WS_BAR, 0, 16384, stream);
    mk::Args a{};
    for (int i = 0; i < 34; ++i) a.in[i] = (const float*)d_in[i];
    a.out = (float*)d_out; a.ws = (unsigned char*)d_ws;
    a.ntail = 32;
#if MK_SPLIT
    for (int ph = 0; ph < mk::NPHASE; ++ph) { a.ph_lo = ph; a.ph_hi = ph + 1; a.flags = 0; hipLaunchKernelGGL(mk::fwd, dim3(grid), dim3(512), mk::LDS_BYTES, stream, a);
#ifdef MK_REP
        if (ph == MK_REP) { a.flags = MK_REP_FLAGS; for (int r = 0; r < MK_REP_N; ++r) hipLaunchKernelGGL(mk::fwd, dim3(grid), dim3(512), mk::LDS_BYTES, stream, a); }
#endif
    }
#else
    a.ph_lo = 0; a.ph_hi = mk::NPHASE;
    hipLaunchKernelGGL(mk::fwd, dim3(grid), dim3(512), mk::LDS_BYTES, stream, a);
#endif
}
```

```cpp
#include <hip/hip_runtime.h>
#include <cstdio>
#include <cstdint>

#ifndef MK_WGM_INPROJ
#define MK_WGM_INPROJ 4
#endif
#ifndef MK_WGM_MOE
#define MK_WGM_MOE 8
#endif
#ifndef MK_SPLIT
#define MK_SPLIT 0
#endif

#define LAS __attribute__((address_space(3)))
typedef unsigned short bf16_t;
typedef short bf16x8 __attribute__((ext_vector_type(8)));
typedef float f32x4 __attribute__((ext_vector_type(4)));
typedef float f32x2 __attribute__((ext_vector_type(2)));
typedef unsigned u32x4 __attribute__((ext_vector_type(4)));
typedef unsigned u32x2 __attribute__((ext_vector_type(2)));

namespace mk {
constexpr int D = 1024, NBATCH = 8, SEQ = 4096, NMETA = 16, L = SEQ + NMETA, TR = NBATCH * SEQ  , MROW = TR  , PROWS = TR + NMETA;
constexpr int LDP = 8704;
constexpr int C_GQ = 0, C_GK = 512, C_GV = 1024, C_GR = 2048, C_RR = 3072, C_RK = 4096, C_RV = 5120, C_GG = 6144, C_GW = 7168,
              C_GA = 8192, C_RW = 8208, C_RA = 8272, C_RG = 8336;
constexpr int NE = 32;
constexpr float EPS = 1e-5f;
constexpr int NPHASE = 12;
__device__ __forceinline__ int prow(int b, int l) { return l < NMETA ? MROW + l : b * SEQ + (l - NMETA); }
constexpr size_t MiB = (size_t)1 << 20;
constexpr size_t WS_BAR = 0;
constexpr size_t WS_CNT = 16 * 1024;
constexpr size_t WS_MISC = 64 * 1024;
constexpr size_t WS_TOPE = 1 * MiB, WS_TOPC = 2 * MiB, WS_POS = 3 * MiB, WS_TOK = 4 * MiB, WS_CW = 5 * MiB;
constexpr size_t WS_WIN = 8 * MiB;
constexpr size_t WS_WGR = 25 * MiB;
constexpr size_t WS_WOUT = 29 * MiB;
constexpr size_t WS_WDEC = 31 * MiB;
constexpr size_t WS_WA2 = 31 * MiB + 128 * 1024;
constexpr size_t WS_WG2 = 31 * MiB + 256 * 1024;
constexpr size_t WS_WRS = 31 * MiB + 704 * 1024;
constexpr size_t WS_XB = 32 * MiB;
constexpr size_t WS_P = 96 * MiB;
constexpr size_t WS_ACT = WS_P, WS_YS = WS_P + 272 * MiB;
constexpr size_t WS_LORA = 641 * MiB;
constexpr size_t LSLOT = 65 * MiB;
constexpr size_t WS_MIX = WS_LORA;
constexpr size_t WS_WGU = WS_LORA;
constexpr size_t WS_U2 = WS_LORA + 130 * MiB;
constexpr size_t WS_WDN = WS_XB;
constexpr size_t WS_R5 = 836 * MiB;
constexpr size_t WS_END = 964 * MiB;
constexpr size_t WS_TAIL = WS_END;

constexpr int LDS_BYTES = 147456;
constexpr int LDS_MISC = 147200;

struct Args { const float* in[34]; float* out; unsigned char* ws; int ph_lo, ph_hi, flags, ntail; };

__device__ __forceinline__ float bf_lo(unsigned w) { return __uint_as_float(w << 16); }
__device__ __forceinline__ float bf_hi(unsigned w) { return __uint_as_float(w & 0xffff0000u); }
__device__ __forceinline__ float bf1(bf16_t v) { return __uint_as_float(((unsigned)v) << 16); }
typedef __bf16 bf16v2 __attribute__((ext_vector_type(2)));
__device__ __forceinline__ unsigned pk2(float lo, float hi) { bf16v2 v; v.x = (__bf16)lo; v.y = (__bf16)hi; return __builtin_bit_cast(unsigned, v); }
__device__ __forceinline__ unsigned f2bf(float f) { const __bf16 b = (__bf16)f; return (unsigned)__builtin_bit_cast(unsigned short, b); }
__device__ __forceinline__ float sigmoidf_(float x) { return __builtin_amdgcn_rcpf(1.0f + __expf(-x)); }
__device__ __forceinline__ float tanhf_(float x) { return 1.0f - 2.0f * __builtin_amdgcn_rcpf(1.0f + __expf(2.0f * x)); }
__device__ __forceinline__ float wave_sum(float v) {
#pragma unroll
    for (int o = 1; o < 64; o <<= 1) v += __shfl_xor(v, o);
    return v;
}
__device__ __forceinline__ int tidx() { int t = threadIdx.x; asm volatile("" : "+v"(t)); return t; }
__device__ __forceinline__ float red16(float v) { v += __shfl_xor(v, 1); v += __shfl_xor(v, 2); v += __shfl_xor(v, 4); v += __shfl_xor(v, 8); return v; }
template <int CTRL> __device__ __forceinline__ float dppf(float v) { return __int_as_float(__builtin_amdgcn_update_dpp(0, __float_as_int(v), CTRL, 0xF, 0xF, true)); }
__device__ __forceinline__ float red8(float v) { v += dppf<0xB1>(v); v += dppf<0x4E>(v); v += dppf<0x141>(v); return v; }

#define XB_TMO      128
#define XB_XCNT(j)  (256  + 64 * (j))
#define XB_XSUB(j)  (1280 + 64 * (j))
#define XB_XGEN(j)  (2304 + 64 * (j))
#define XB_TOP      3328
#define XB_TOPGEN   3392
#define XCD_BAR_WORDS 3456
#define XB_RDY      3456
#define XB_SPIN_CAP (1u << 22)
__device__ __forceinline__ unsigned xb_ld(unsigned* p)              { return __hip_atomic_load(p, __ATOMIC_RELAXED, __HIP_MEMORY_SCOPE_AGENT); }
__device__ __forceinline__ unsigned xb_add(unsigned* p, unsigned v) { return __hip_atomic_fetch_add(p, v, __ATOMIC_RELAXED, __HIP_MEMORY_SCOPE_AGENT); }
__device__ __forceinline__ unsigned xb_xcc_id() { return (unsigned)__builtin_amdgcn_s_getreg((3 << 11) | 20) & 0xFu; }
#define XB_SPIN(cond, bar) do { unsigned _sp = 0; while (cond) { __builtin_amdgcn_s_sleep(1); \
    if ((++_sp & 255u) == 0u) { if (xb_ld(&(bar)[XB_TMO])) break; if (_sp > XB_SPIN_CAP) { atomicAdd(&(bar)[XB_TMO], 1u); break; } } } } while (0)
struct XcdBarrier { unsigned* bar; unsigned x; volatile LAS unsigned* st; };
__device__ __forceinline__ XcdBarrier xcd_barrier_post(unsigned* bar, volatile LAS unsigned* st) {
    XcdBarrier b; b.bar = bar; b.x = xb_xcc_id(); b.st = st;
    if (threadIdx.x == 0) (void)xb_add(&bar[XB_XCNT(b.x)], 1u);
    return b;
}
__device__ __forceinline__ void xcd_barrier_complete(unsigned* bar, unsigned x, unsigned& nloc, unsigned& nx) {
    const unsigned G = gridDim.x * gridDim.y * gridDim.z;
    unsigned sum, cnt, mine, sp = 0u;
    for (;;) {
        sum = 0u; cnt = 0u; mine = 0u;
#pragma unroll
        for (unsigned j = 0; j < 16; ++j) { const unsigned c = xb_ld(&bar[XB_XCNT(j)]); sum += c; cnt += (c > 0u) ? 1u : 0u; mine = (j == x) ? c : mine; }
        if (sum == G) break;
        __builtin_amdgcn_s_sleep(1);
        if ((++sp & 255u) == 0u) { if (xb_ld(&bar[XB_TMO])) break; if (sp > XB_SPIN_CAP) { atomicAdd(&bar[XB_TMO], 1u); break; } }
    }
    nloc = mine > 0u ? mine : 1u; nx = cnt > 0u ? cnt : 1u;
}
__device__ __forceinline__ void xcd_barrier(const XcdBarrier& b) {
    asm volatile("s_waitcnt vmcnt(0)" ::: "memory");
    __syncthreads();
    if (threadIdx.x == 0) {
        unsigned* bar = b.bar;
        __builtin_amdgcn_s_waitcnt(0);
        unsigned nloc = b.st[0], nx = b.st[1];
        if (nloc == 0u) { xcd_barrier_complete(bar, b.x, nloc, nx); b.st[0] = nloc; b.st[1] = nx; }
        const unsigned old = xb_add(&bar[XB_XSUB(b.x)], 1u);
        const unsigned gen = old / nloc;
        if (old + 1u == (gen + 1u) * nloc) {
            __builtin_amdgcn_fence(__ATOMIC_RELEASE, "agent");
            asm volatile("s_waitcnt vmcnt(0)" ::: "memory");
            const unsigned og = xb_add(&bar[XB_TOP], 1u);
            const unsigned tg = og / nx;
            if (og + 1u == (tg + 1u) * nx) xb_add(&bar[XB_TOPGEN], 1u);
            else XB_SPIN(xb_ld(&bar[XB_TOPGEN]) == tg, bar);
            __builtin_amdgcn_fence(__ATOMIC_ACQUIRE, "agent");
            xb_add(&bar[XB_XGEN(b.x)], 1u);
            asm volatile("s_waitcnt vmcnt(0)" ::: "memory");
        } else {
            XB_SPIN(xb_ld(&bar[XB_XGEN(b.x)]) == gen, bar);
            __builtin_amdgcn_fence(__ATOMIC_ACQUIRE, "agent");
            asm volatile("s_waitcnt vmcnt(0)" ::: "memory");
        }
    }
    __syncthreads();
}

namespace pg8 {
constexpr int BM = 256, BK = 64, HALF = 128, HTB = HALF * BK * 2, STAGE_BYTES = 8 * HTB, NXCD = 8, WGM = 8;
__host__ __device__ __forceinline__ int lds_byte(int r, int c) { const int st = (r >> 4) * 2 + (c >> 5), rr = r & 15, cc = c & 31, ob = rr * 64 + cc * 2; return st * 1024 + (ob ^ (((ob >> 9) & 1) << 5)); }
__host__ __device__ __forceinline__ void stage_rc(int b, int& R, int& C) { const int st = b / 1024, sb = b % 1024, swz = sb ^ (((sb >> 9) & 1) << 5); R = (st >> 1) * 16 + swz / 64; C = (st & 1) * 32 + (swz % 64) / 2; }
__host__ __device__ __forceinline__ int perm32(int rho) { const int n = rho >> 4, i = rho & 15; return 8 * (i >> 2) + 4 * n + (i & 3); }
struct Unit { int pm, pn, e; };
struct StaticOrder {
    int nM, nN, nwg, G, c, wgm;
    __device__ __forceinline__ void init(int nM_, int nN_, int G_, int c_, int wgm_ = WGM) { nM = nM_; nN = nN_; nwg = nM * nN; G = G_; c = c_; wgm = wgm_; }
    __device__ __forceinline__ bool next(int i, Unit& u) const {
        const long Lx = (long)i * G + c; if (Lx >= nwg) return false;
        int wgid = (int)Lx; { const int q = nwg / NXCD, r = nwg % NXCD, xcd = wgid % NXCD, off = wgid / NXCD; wgid = (xcd < r ? xcd * (q + 1) : r * (q + 1) + (xcd - r) * q) + off; }
        const int nig = wgm * nN, gid = wgid / nig, fm = gid * wgm, gsz = (nM - fm) < wgm ? (nM - fm) : wgm;
        u.pm = fm + ((wgid % nig) % gsz); u.pn = (wgid % nig) / gsz; return true;
    }
};
__device__ __forceinline__ unsigned cvt_pk_bf16(float lo, float hi) { return pk2(lo, hi); }

struct ProbDense {
    const bf16_t* A; int lda; const bf16_t* Bt; int ldb; StaticOrder so;
    __device__ __forceinline__ bool next(int i, Unit& u) const { u.e = 0; return so.next(i, u); }
    __device__ __forceinline__ const char* a_base(const Unit& u) const { return (const char*)(A + (size_t)u.pm * 256 * lda); }
    __device__ __forceinline__ const char* b_base(const Unit& u) const { return (const char*)(Bt + (size_t)u.pn * 256 * ldb); }
    __device__ __forceinline__ void a_ready(int, const Unit&, int) const {}
    __device__ __forceinline__ void a_off(const Unit&, const int (&R)[2], const int (&C)[2], unsigned (&v)[2][2]) const {
#pragma unroll
        for (int h = 0; h < 2; ++h)
#pragma unroll
            for (int i = 0; i < 2; ++i) v[h][i] = (unsigned)(((h * HALF + R[i]) * lda + C[i]) * 2);
    }
};
struct ProbMix {
    const bf16_t* A; const bf16_t* Bt; StaticOrder so;
    __device__ __forceinline__ bool next(int i, Unit& u) const { if (!so.next(i >> 1, u)) return false; u.e = i & 1; return true; }
    __device__ __forceinline__ const char* a_base(const Unit& u) const { return (const char*)(A + (size_t)u.pm * 256 * 2048 + u.e * 1024); }
    __device__ __forceinline__ const char* b_base(const Unit& u) const { return (const char*)(Bt + (size_t)u.e * 1024 * 1024 + (size_t)u.pn * 256 * 1024); }
    __device__ __forceinline__ void a_ready(int, const Unit&, int) const {}
    __device__ __forceinline__ void a_off(const Unit&, const int (&R)[2], const int (&C)[2], unsigned (&v)[2][2]) const {
#pragma unroll
        for (int h = 0; h < 2; ++h)
#pragma unroll
            for (int i = 0; i < 2; ++i) v[h][i] = (unsigned)(((h * HALF + R[i]) * 2048 + C[i]) * 2);
    }
};
struct ProbMoE {
    const bf16_t* A; const int* tok; const bf16_t* Bt; const bf16_t* Bt2; int ntail; int nN; const int* tile2e; StaticOrder so;
    unsigned* rdy; unsigned need, mask;
    __device__ __forceinline__ void a_ready(int i, const Unit& u, int wid) const {
        if (rdy == nullptr || (i < 32 && ((mask >> i) & 1u))) return;
        if (wid == 0) { unsigned sp = 0u;
            while ((unsigned)__builtin_amdgcn_readfirstlane(xb_ld(rdy + u.pm)) < need) { __builtin_amdgcn_s_sleep(2); if (++sp > XB_SPIN_CAP) break; }
            __builtin_amdgcn_fence(__ATOMIC_ACQUIRE, "agent");
            asm volatile("s_waitcnt vmcnt(0)" ::: "memory"); }
        asm volatile("" ::: "memory"); __builtin_amdgcn_s_barrier(); asm volatile("" ::: "memory");
    }
    __device__ __forceinline__ bool next(int i, Unit& u) const { if (!so.next(i, u)) return false; u.e = __builtin_amdgcn_readfirstlane(tile2e[u.pm]); return true; }
    __device__ __forceinline__ const char* a_base(const Unit& u) const { return tok ? (const char*)A : (const char*)(A + (size_t)u.pm * 256 * 1024); }
    __device__ __forceinline__ const char* b_base(const Unit& u) const { return (u.e < ntail) ? (const char*)(Bt2 + ((size_t)u.e * nN + u.pn) * 256 * 1024) : (const char*)(Bt + ((size_t)(u.e - ntail) * nN + u.pn) * 256 * 1024); }
    __device__ __forceinline__ void a_off(const Unit& u, const int (&R)[2], const int (&C)[2], unsigned (&v)[2][2]) const {
#pragma unroll
        for (int h = 0; h < 2; ++h)
#pragma unroll
            for (int i = 0; i < 2; ++i) { const int row = tok ? tok[u.pm * 256 + h * HALF + R[i]] : (h * HALF + R[i]); v[h][i] = (unsigned)((row * 1024 + C[i]) * 2); }
    }
};

typedef f32x4 Acc[2][2][4][2];

template <class Epi, class Prob, int K>
__device__ __forceinline__ void gemm_phase(LAS unsigned char* lds, const Prob& S, const Epi& E) {
    const int tid = tidx(), wid = __builtin_amdgcn_readfirstlane(tid >> 6), lane = tid & 63, wr = wid >> 2, wc = wid & 3, fr = lane & 15, fq = lane >> 4;
    constexpr int nt = K / BK;
    int R[2], C[2]; unsigned voffB[2];
#pragma unroll
    for (int i = 0; i < 2; ++i) { stage_rc(tid * 16 + i * 8192, R[i], C[i]); const int Rb = Epi::PERM ? ((R[i] & ~31) + perm32(R[i] & 31)) : R[i]; voffB[i] = (unsigned)(Rb * K + C[i]) * 2u; }
    const size_t kstep = (size_t)(BK * 2);
    const size_t hstep = (size_t)HALF * K * 2;
    const unsigned ldsw = (unsigned)wid * 1024u;
    const int aoff = lds_byte(wr * 64 + fr, fq * 8), boff = lds_byte(wc * 32 + fr, fq * 8);
#define PG8_SA(b, h) (((b) * 2 + (h)) * HTB)
#define PG8_SB(b, h) ((4 + (b) * 2 + (h)) * HTB)
#define PG8_STAGE(bufoff, gbase, voff) do { _Pragma("unroll") for (int _i = 0; _i < 2; ++_i) \
        __builtin_amdgcn_global_load_lds((const unsigned*)((const char*)(gbase) + (voff)[_i]), (LAS unsigned*)(lds + (bufoff) + ldsw + _i * 8192), 16, 0, 0); } while (0)
#define PG8_LDA(dst, b, h) do { _Pragma("unroll") for (int m = 0; m < 4; ++m) _Pragma("unroll") for (int k = 0; k < 2; ++k) dst[m][k] = *(const LAS bf16x8*)(lds + PG8_SA(b, h) + aoff + m * 2048 + k * 1024); } while (0)
#define PG8_LDB(dst, b, h) do { _Pragma("unroll") for (int n = 0; n < 2; ++n) _Pragma("unroll") for (int k = 0; k < 2; ++k) dst[n][k] = *(const LAS bf16x8*)(lds + PG8_SB(b, h) + boff + n * 2048 + k * 1024); } while (0)
#define PG8_MMA(ai, bj, At, Bt) do { __builtin_amdgcn_s_setprio(1); _Pragma("unroll") for (int m = 0; m < 4; ++m) _Pragma("unroll") for (int n = 0; n < 2; ++n) _Pragma("unroll") for (int k = 0; k < 2; ++k) \
        acc[ai][bj][m][n] = __builtin_amdgcn_mfma_f32_16x16x32_bf16(Bt[n][k], At[m][k], acc[ai][bj][m][n], 0, 0, 0); __builtin_amdgcn_s_setprio(0); } while (0)
#define PG8_WAIT_V(n) asm volatile("s_waitcnt vmcnt(" #n ")" ::: "memory")
#define PG8_WAIT_L(n) asm volatile("s_waitcnt lgkmcnt(" #n ")" ::: "memory")
#define PG8_BAR __builtin_amdgcn_s_barrier()
#define PG8_SCHED __builtin_amdgcn_sched_barrier(0)
    Unit cur, nxt; int ui = 0;
    if (!S.next(0, cur)) return;
    Acc acc;
#pragma unroll
    for (int a = 0; a < 2; ++a)
#pragma unroll
        for (int b = 0; b < 2; ++b)
#pragma unroll
            for (int m = 0; m < 4; ++m)
#pragma unroll
                for (int n = 0; n < 2; ++n) acc[a][b][m][n] = (f32x4){0.f, 0.f, 0.f, 0.f};
    bf16x8 At[4][2], B0[2][2], B1[2][2];
    unsigned va[2][2], vn[2][2];
    S.a_off(cur, R, C, va);
    const char* cA = S.a_base(cur); const char* cB = S.b_base(cur);
    int pend = -1;
    S.a_ready(0, cur, wid);
    PG8_STAGE(PG8_SB(0, 0), cB, voffB); PG8_STAGE(PG8_SB(0, 1), cB + hstep, voffB); PG8_STAGE(PG8_SA(0, 0), cA, va[0]); PG8_STAGE(PG8_SA(0, 1), cA, va[1]);
    if (wr == 1) PG8_BAR;
    PG8_WAIT_V(2); PG8_BAR;
    PG8_STAGE(PG8_SB(1, 0), cB + kstep, voffB); PG8_STAGE(PG8_SA(1, 0), cA + kstep, va[0]); PG8_STAGE(PG8_SB(1, 1), cB + hstep + kstep, voffB);
    PG8_WAIT_V(6); PG8_BAR;
    for (;;) {
        const bool has_next = S.next(ui + 1, nxt);
        const char* nA = cA; const char* nB = cB;
#pragma unroll
        for (int h = 0; h < 2; ++h)
#pragma unroll
            for (int i = 0; i < 2; ++i) vn[h][i] = va[h][i];
        if (has_next) { nA = S.a_base(nxt); nB = S.b_base(nxt); S.a_off(nxt, R, C, vn); }
        for (int t = 0; t < nt; t += 2) {
            const bool last = (t == nt - 2);
            const char* a1 = cA + (size_t)(t + 1) * kstep;
            const char* a2 = last ? nA : cA + (size_t)(t + 2) * kstep; const char* b2 = last ? nB : cB + (size_t)(t + 2) * kstep;
            const char* a3 = a2 + kstep; const char* b3 = b2 + kstep;
            unsigned v2[2][2];
#pragma unroll
            for (int h = 0; h < 2; ++h)
#pragma unroll
                for (int i = 0; i < 2; ++i) v2[h][i] = last ? vn[h][i] : va[h][i];
            if constexpr (Epi::PUB) { if (t == 4 && pend >= 0) { E.publish(pend, lane); pend = -1; } }
            if (last && has_next) S.a_ready(ui + 1, nxt, wid);
            PG8_LDB(B0, 0, 0); PG8_LDB(B1, 0, 1); PG8_SCHED; PG8_LDA(At, 0, 0); PG8_STAGE(PG8_SA(1, 1), a1, va[1]);
            PG8_WAIT_V(8); PG8_WAIT_L(0); PG8_BAR; PG8_MMA(0, 0, At, B0); PG8_MMA(0, 1, At, B1); PG8_BAR; PG8_SCHED;
            PG8_LDA(At, 0, 1); PG8_STAGE(PG8_SB(0, 0), b2, voffB); PG8_STAGE(PG8_SB(0, 1), b2 + hstep, voffB); PG8_STAGE(PG8_SA(0, 0), a2, v2[0]);
            PG8_WAIT_V(8); PG8_WAIT_L(0); PG8_BAR; PG8_MMA(1, 0, At, B0); PG8_MMA(1, 1, At, B1); PG8_BAR; PG8_SCHED;
            PG8_LDB(B0, 1, 0); PG8_LDB(B1, 1, 1); PG8_SCHED; PG8_LDA(At, 1, 0); PG8_STAGE(PG8_SA(0, 1), a2, v2[1]);
            PG8_WAIT_V(8); PG8_WAIT_L(0); PG8_BAR; PG8_MMA(0, 0, At, B0); PG8_MMA(0, 1, At, B1); PG8_BAR; PG8_SCHED;
            PG8_LDA(At, 1, 1); PG8_STAGE(PG8_SB(1, 0), b3, voffB); PG8_STAGE(PG8_SB(1, 1), b3 + hstep, voffB); PG8_STAGE(PG8_SA(1, 0), a3, v2[0]);
            PG8_WAIT_V(8); PG8_WAIT_L(0); PG8_BAR; PG8_MMA(1, 0, At, B0); PG8_MMA(1, 1, At, B1); PG8_BAR; PG8_SCHED;
        }
        if (wr == 0) PG8_BAR;
        E(acc, cur, wr, wc, fr, fq);
        if constexpr (Epi::PUB) pend = cur.pm;
        if (!has_next) break;
        if (!(Epi::KEEP && cur.e == 0)) {
#pragma unroll
        for (int a = 0; a < 2; ++a)
#pragma unroll
            for (int b = 0; b < 2; ++b)
#pragma unroll
                for (int m = 0; m < 4; ++m)
#pragma unroll
                    for (int n = 0; n < 2; ++n) acc[a][b][m][n] = (f32x4){0.f, 0.f, 0.f, 0.f};
        }
        cur = nxt; cA = nA; cB = nB; ++ui;
#pragma unroll
        for (int h = 0; h < 2; ++h)
#pragma unroll
            for (int i = 0; i < 2; ++i) va[h][i] = vn[h][i];
        if (wr == 1) PG8_BAR;
    }
    PG8_WAIT_V(0);
    if constexpr (Epi::PUB) { if (pend >= 0) E.publish(pend, lane); }
    PG8_BAR;
#undef PG8_SA
#undef PG8_SB
#undef PG8_STAGE
#undef PG8_LDA
#undef PG8_LDB
#undef PG8_MMA
#undef PG8_WAIT_V
#undef PG8_WAIT_L
#undef PG8_BAR
#undef PG8_SCHED
}

struct EpiBf16 {
    static constexpr bool PERM = true, KEEP = false, PUB = false; static constexpr int NST = 16;
    bf16_t* O; int ldc;
    __device__ __forceinline__ void operator()(Acc& acc, const Unit& u, int wr, int wc, int fr, int fq) const {
        const int row0 = u.pm * BM + wr * 64 + fr, col0 = u.pn * BM + wc * 32 + 8 * fq;
#pragma unroll
        for (int ai = 0; ai < 2; ++ai)
#pragma unroll
            for (int m = 0; m < 4; ++m) { bf16_t* rowp = O + (size_t)(row0 + ai * HALF + m * 16) * ldc + col0;
#pragma unroll
                for (int bj = 0; bj < 2; ++bj) { const f32x4 v0 = acc[ai][bj][m][0], v1 = acc[ai][bj][m][1];
                    u32x4 w; w.x = cvt_pk_bf16(v0[0], v0[1]); w.y = cvt_pk_bf16(v0[2], v0[3]); w.z = cvt_pk_bf16(v1[0], v1[1]); w.w = cvt_pk_bf16(v1[2], v1[3]);
                    *(u32x4*)(rowp + bj * HALF) = w; } }
    }
};
struct EpiMix {
    static constexpr bool PERM = true, KEEP = true, PUB = false; static constexpr int NST = 16;
    const bf16_t* P; bf16_t* O;
    __device__ __forceinline__ void operator()(Acc& acc, const Unit& u, int wr, int wc, int fr, int fq) const { if (u.e == 0) first(acc, u, wr, wc, fr, fq); else second(acc, u, wr, wc, fr, fq); }
    __device__ __forceinline__ void first(Acc& acc, const Unit& u, int wr, int wc, int fr, int fq) const {
        const int row0 = u.pm * BM + wr * 64 + fr, col0 = u.pn * BM + wc * 32 + 8 * fq;
#pragma unroll
        for (int ai = 0; ai < 2; ++ai)
#pragma unroll
            for (int m = 0; m < 4; ++m) { const bf16_t* rowp = P + (size_t)(row0 + ai * HALF + m * 16) * LDP + col0;
#pragma unroll
                for (int bj = 0; bj < 2; ++bj) {
                    const u32x4 g1 = *(const u32x4*)(rowp + C_GG + bj * HALF), g2 = *(const u32x4*)(rowp + C_GW + bj * HALF);
                    float a[8], b[8];
                    a[0] = bf_lo(g1.x); a[1] = bf_hi(g1.x); a[2] = bf_lo(g1.y); a[3] = bf_hi(g1.y); a[4] = bf_lo(g1.z); a[5] = bf_hi(g1.z); a[6] = bf_lo(g1.w); a[7] = bf_hi(g1.w);
                    b[0] = bf_lo(g2.x); b[1] = bf_hi(g2.x); b[2] = bf_lo(g2.y); b[3] = bf_hi(g2.y); b[4] = bf_lo(g2.z); b[5] = bf_hi(g2.z); b[6] = bf_lo(g2.w); b[7] = bf_hi(g2.w);
#pragma unroll
                    for (int j = 0; j < 8; ++j) { const float ratio = (1.0f + __expf(-b[j])) * __builtin_amdgcn_rcpf(1.0f + __expf(-a[j])); acc[ai][bj][m][j >> 2][j & 3] *= ratio; }
                } }
    }
    __device__ __forceinline__ void second(Acc& acc, const Unit& u, int wr, int wc, int fr, int fq) const {
        const int row0 = u.pm * BM + wr * 64 + fr, col0 = u.pn * BM + wc * 32 + 8 * fq;
#pragma unroll
        for (int ai = 0; ai < 2; ++ai)
#pragma unroll
            for (int m = 0; m < 4; ++m) { const size_t r = (size_t)(row0 + ai * HALF + m * 16);
#pragma unroll
                for (int bj = 0; bj < 2; ++bj) {
                    const u32x4 g2 = *(const u32x4*)(P + r * LDP + col0 + C_GW + bj * HALF);
                    float b[8];
                    b[0] = bf_lo(g2.x); b[1] = bf_hi(g2.x); b[2] = bf_lo(g2.y); b[3] = bf_hi(g2.y); b[4] = bf_lo(g2.z); b[5] = bf_hi(g2.z); b[6] = bf_lo(g2.w); b[7] = bf_hi(g2.w);
                    float o[8];
#pragma unroll
                    for (int j = 0; j < 8; ++j) o[j] = acc[ai][bj][m][j >> 2][j & 3] * sigmoidf_(b[j]);
                    u32x4 w; w.x = cvt_pk_bf16(o[0], o[1]); w.y = cvt_pk_bf16(o[2], o[3]); w.z = cvt_pk_bf16(o[4], o[5]); w.w = cvt_pk_bf16(o[6], o[7]);
                    *(u32x4*)(O + r * D + col0 + bj * HALF) = w; } }
    }
};
struct EpiH2 {
    static constexpr bool PERM = true, KEEP = false, PUB = false; static constexpr int NST = 16;
    const float* x; bf16_t* O;
    __device__ __forceinline__ void operator()(Acc& acc, const Unit& u, int wr, int wc, int fr, int fq) const {
        const int row0 = u.pm * BM + wr * 64 + fr, col0 = u.pn * BM + wc * 32 + 8 * fq;
        u32x4 pk[2][4][2];
#pragma unroll
        for (int ai = 0; ai < 2; ++ai)
#pragma unroll
            for (int m = 0; m < 4; ++m)
#pragma unroll
                for (int bj = 0; bj < 2; ++bj) { const f32x4 v0 = acc[ai][bj][m][0], v1 = acc[ai][bj][m][1];
                    pk[ai][m][bj] = (u32x4){cvt_pk_bf16(v0[0], v0[1]), cvt_pk_bf16(v0[2], v0[3]), cvt_pk_bf16(v1[0], v1[1]), cvt_pk_bf16(v1[2], v1[3])}; }
#pragma unroll
        for (int ai = 0; ai < 2; ++ai) {
            f32x4 xv[4][2][2];
#pragma unroll
            for (int m = 0; m < 4; ++m)
#pragma unroll
                for (int bj = 0; bj < 2; ++bj) { const float* src = x + (size_t)(row0 + ai * HALF + m * 16) * D + col0 + bj * HALF; xv[m][bj][0] = *(const f32x4*)src; xv[m][bj][1] = *(const f32x4*)(src + 4); }
#pragma unroll
            for (int m = 0; m < 4; ++m)
#pragma unroll
                for (int bj = 0; bj < 2; ++bj) { const u32x4 q = pk[ai][m][bj]; const f32x4 a0 = xv[m][bj][0], a1 = xv[m][bj][1];
                    u32x4 w; w.x = cvt_pk_bf16(a0[0] + bf_lo(q.x), a0[1] + bf_hi(q.x)); w.y = cvt_pk_bf16(a0[2] + bf_lo(q.y), a0[3] + bf_hi(q.y));
                    w.z = cvt_pk_bf16(a1[0] + bf_lo(q.z), a1[1] + bf_hi(q.z)); w.w = cvt_pk_bf16(a1[2] + bf_lo(q.w), a1[3] + bf_hi(q.w));
                    *(u32x4*)(O + (size_t)(row0 + ai * HALF + m * 16) * D + col0 + bj * HALF) = w; }
        }
    }
};
struct EpiSwiglu {
    static constexpr bool PERM = true, KEEP = false, PUB = true; static constexpr int NST = 8;
    const float* bgu; bf16_t* O; unsigned* rdy;
    __device__ __forceinline__ void publish(int pm, int lane) const { if (lane == 0) __hip_atomic_fetch_add(rdy + pm, 1u, __ATOMIC_RELAXED, __HIP_MEMORY_SCOPE_AGENT); }
    __device__ __forceinline__ void operator()(Acc& acc, const Unit& u, int wr, int wc, int fr, int fq) const {
        const int row0 = u.pm * BM + wr * 64 + fr, d0 = u.pn * HALF + wc * 32 + 8 * fq;
        const float* bg = bgu + (size_t)u.e * 2048 + d0;
        const __amdgpu_buffer_rsrc_t rs = __builtin_amdgcn_make_buffer_rsrc((void*)O, (short)0, 0x7ffffff0, 0x00020000);
        float bgate[8], bup[8];
        { const f32x4 t0 = *(const f32x4*)bg, t1 = *(const f32x4*)(bg + 4), t2 = *(const f32x4*)(bg + 1024), t3 = *(const f32x4*)(bg + 1028);
#pragma unroll
          for (int j = 0; j < 4; ++j) { bgate[j] = t0[j]; bgate[4 + j] = t1[j]; bup[j] = t2[j]; bup[4 + j] = t3[j]; } }
#pragma unroll
        for (int ai = 0; ai < 2; ++ai)
#pragma unroll
            for (int m = 0; m < 4; ++m) { const size_t r = (size_t)(row0 + ai * HALF + m * 16);
                float o[8];
#pragma unroll
                for (int j = 0; j < 8; ++j) {
                    float g = acc[ai][0][m][j >> 2][j & 3] + bgate[j], up = acc[ai][1][m][j >> 2][j & 3] + bup[j];
                    g = fminf(g, 7.0f); up = fminf(fmaxf(up, -7.0f), 7.0f);
                    o[j] = (up + 1.0f) * (g * sigmoidf_(1.702f * g)); }
                u32x4 w; w.x = cvt_pk_bf16(o[0], o[1]); w.y = cvt_pk_bf16(o[2], o[3]); w.z = cvt_pk_bf16(o[4], o[5]); w.w = cvt_pk_bf16(o[6], o[7]);
                __builtin_amdgcn_raw_buffer_store_b128(w, rs, (int)(((unsigned)r * D + d0) * 2u), 0, 16); }
    }
};
struct EpiDown {
    static constexpr bool PERM = true, KEEP = false, PUB = false; static constexpr int NST = 16;
    const float* bdn; const float* cw; bf16_t* O;
    __device__ __forceinline__ void operator()(Acc& acc, const Unit& u, int wr, int wc, int fr, int fq) const {
        const int row0 = u.pm * BM + wr * 64 + fr, col0 = u.pn * BM + wc * 32 + 8 * fq;
        const float* bb = bdn + (size_t)u.e * D + col0;
        float bias[2][8];
#pragma unroll
        for (int bj = 0; bj < 2; ++bj) { const f32x4 t0 = *(const f32x4*)(bb + bj * HALF), t1 = *(const f32x4*)(bb + bj * HALF + 4);
#pragma unroll
            for (int j = 0; j < 4; ++j) { bias[bj][j] = t0[j]; bias[bj][4 + j] = t1[j]; } }
#pragma unroll
        for (int ai = 0; ai < 2; ++ai)
#pragma unroll
            for (int m = 0; m < 4; ++m) { const size_t r = (size_t)(row0 + ai * HALF + m * 16); const float c = cw[r];
#pragma unroll
                for (int bj = 0; bj < 2; ++bj) { float o[8];
#pragma unroll
                    for (int j = 0; j < 8; ++j) o[j] = (acc[ai][bj][m][j >> 2][j & 3] + bias[bj][j]) * c;
                    u32x4 w; w.x = cvt_pk_bf16(o[0], o[1]); w.y = cvt_pk_bf16(o[2], o[3]); w.z = cvt_pk_bf16(o[4], o[5]); w.w = cvt_pk_bf16(o[6], o[7]);
                    *(u32x4*)(O + r * D + col0 + bj * HALF) = w; } }
    }
};
}

__device__ __forceinline__ int win_srccol(int n) {
    if (n < 3072) return n;
    if (n < 6144) return 3088 + (n - 3072);
    if (n < 8192) return 6448 + (n - 6144);
    if (n < 8208) return 3072 + (n - 8192);
    if (n < 8496) return 6160 + (n - 8208);
    return -1;
}
template <int MODE>
__device__ __forceinline__ void tr_item(const float* src, int ld, int kvalid, bf16_t* dst, int dld, int k0, int n0, const float* scale, int lane) {
    const int kr = lane >> 3, c4 = (lane & 7) * 4, n = n0 + c4, kb = k0 + 8 * kr;
    int sc;
    if (MODE == 0) sc = n; else if (MODE == 1) sc = win_srccol(n); else { const int pn = n >> 8, r = n & 255, d = pn * 128 + (r & 127); sc = (r < 128) ? d : 1024 + d; }
    f32x4 v[8];
#pragma unroll
    for (int i = 0; i < 8; ++i) { v[i] = (f32x4){0.f, 0.f, 0.f, 0.f}; if (sc >= 0 && kb + i < kvalid) v[i] = *(const f32x4*)(src + (size_t)(kb + i) * ld + sc); }
    if (scale) { const f32x4 s0 = *(const f32x4*)(scale + kb), s1 = *(const f32x4*)(scale + kb + 4);
#pragma unroll
        for (int i = 0; i < 4; ++i) { v[i] = v[i] * s0[i]; v[4 + i] = v[4 + i] * s1[i]; } }
#pragma unroll
    for (int j = 0; j < 4; ++j) {
        u32x4 o; o.x = pk2(v[0][j], v[1][j]); o.y = pk2(v[2][j], v[3][j]); o.z = pk2(v[4][j], v[5][j]); o.w = pk2(v[6][j], v[7][j]);
        *(u32x4*)(dst + (size_t)(n + j) * dld + kb) = o; }
}

__device__ __forceinline__ void phase_prologue(const Args& a, LAS unsigned char* lds) {
    unsigned char* ws = a.ws;
    const int tid = tidx(), wave = tid >> 6, lane = tid & 63;
    { const float* wrt = a.in[27]; const float* gfn = a.in[26]; bf16_t* wrs = (bf16_t*)(ws + WS_WRS);
      for (int i = blockIdx.x * 512 + tid; i < 1024 * 32; i += gridDim.x * 512) { const int k = i >> 5, e = i & 31; const float w = wrt[i] * gfn[k]; const unsigned hi = f2bf(w);
          wrs[e * 1024 + k] = (bf16_t)hi; wrs[32768 + e * 1024 + k] = (bf16_t)f2bf(w - bf1((bf16_t)hi)); } }
    const int gw = blockIdx.x * 8 + wave, NGW = gridDim.x * 8;
    constexpr int J_WIN = 16 * 272, J_SQ = 16 * 32, J_LR = 32, J_G2 = 96;
    constexpr int NJ = J_WIN + 3 * J_SQ + 2 * J_LR + J_G2;
    for (int job = gw; job < NJ; job += NGW) {
        int r = job;
        if (r < J_WIN) { tr_item<1>(a.in[3], 8496, 1024, (bf16_t*)(ws + WS_WIN), 1024, (r % 16) * 64, (r / 16) * 32, a.in[2], lane); continue; } r -= J_WIN;
        if (r < J_SQ) { tr_item<0>(a.in[7], 1024, 1024, (bf16_t*)(ws + WS_WGR), 1024, (r % 16) * 64, (r / 16) * 32, nullptr, lane); continue; } r -= J_SQ;
        if (r < J_SQ) { tr_item<0>(a.in[24], 1024, 1024, (bf16_t*)(ws + WS_WGR) + 1024 * 1024, 1024, (r % 16) * 64, (r / 16) * 32, nullptr, lane); continue; } r -= J_SQ;
        if (r < J_SQ) { tr_item<0>(a.in[25], 1024, 1024, (bf16_t*)(ws + WS_WOUT), 1024, (r % 16) * 64, (r / 16) * 32, nullptr, lane); continue; } r -= J_SQ;
        if (r < J_LR) { tr_item<0>(a.in[14], 1024, 64, (bf16_t*)(ws + WS_WDEC), 64, 0, r * 32, nullptr, lane); continue; } r -= J_LR;
        if (r < J_LR) { tr_item<0>(a.in[16], 1024, 64, (bf16_t*)(ws + WS_WA2), 64, 0, r * 32, nullptr, lane); continue; } r -= J_LR;
        tr_item<0>(a.in[18], 1024, 160, (bf16_t*)(ws + WS_WG2), 192, (r % 3) * 64, (r / 3) * 32, nullptr, lane);
    }
    bf16_t* XB = (bf16_t*)(ws + WS_XB);
    for (int row = gw; row < TR; row += NGW) {
        u32x2* o = (u32x2*)(XB + (size_t)row * D) + lane;
        const float* srcp = a.in[0] + (size_t)row * D;
        f32x4 v[4]; float s = 0.f;
#pragma unroll
        for (int j = 0; j < 4; ++j) { v[j] = ((const f32x4*)srcp)[lane + 64 * j]; s += (v[j].x * v[j].x + v[j].y * v[j].y) + (v[j].z * v[j].z + v[j].w * v[j].w); }
        const float rstd = rsqrtf(wave_sum(s) * (1.0f / D) + EPS);
#pragma unroll
        for (int j = 0; j < 4; ++j) o[64 * j] = (u32x2){pk2(v[j].x * rstd, v[j].y * rstd), pk2(v[j].z * rstd, v[j].w * rstd)};
    }
    __syncthreads();
    LAS float* UM = (LAS float*)lds;
    LAS float* RED = UM + 1024 * 16;
    { const float* gmix = a.in[2];
#pragma unroll
      for (int rr = 0; rr < 2; ++rr) { const int l = wave * 2 + rr; const float* srcp = a.in[1] + (size_t)l * D; float x[16]; float s = 0.f;
#pragma unroll
          for (int m = 0; m < 16; ++m) { x[m] = srcp[lane + 64 * m]; s += x[m] * x[m]; }
          const float rstd = rsqrtf(wave_sum(s) * (1.0f / D) + EPS);
#pragma unroll
          for (int m = 0; m < 16; ++m) { const int k = lane + 64 * m; UM[k * 16 + l] = x[m] * rstd * gmix[k]; } } }
    __syncthreads();
    bf16_t* P = (bf16_t*)(ws + WS_P);
    for (int cg = blockIdx.x; cg < 256; cg += gridDim.x) {
        const int n0 = cg * 34, kq = tid >> 5, c = tid & 31;
        const int sA = win_srccol(n0 + c), sB = (c < 2) ? win_srccol(n0 + 32 + c) : -1;
        float accA[16], accB[16];
#pragma unroll
        for (int l = 0; l < 16; ++l) { accA[l] = 0.f; accB[l] = 0.f; }
#pragma unroll 4
        for (int k = kq; k < 1024; k += 16) {
            const float wA = (sA >= 0) ? a.in[3][(size_t)k * 8496 + sA] : 0.f, wB = (sB >= 0) ? a.in[3][(size_t)k * 8496 + sB] : 0.f;
            const f32x4 u0 = *(const LAS f32x4*)(UM + k * 16), u1 = *(const LAS f32x4*)(UM + k * 16 + 4), u2 = *(const LAS f32x4*)(UM + k * 16 + 8), u3 = *(const LAS f32x4*)(UM + k * 16 + 12);
#pragma unroll
            for (int j = 0; j < 4; ++j) { accA[j] += u0[j] * wA; accA[4 + j] += u1[j] * wA; accA[8 + j] += u2[j] * wA; accA[12 + j] += u3[j] * wA;
                                          accB[j] += u0[j] * wB; accB[4 + j] += u1[j] * wB; accB[8 + j] += u2[j] * wB; accB[12 + j] += u3[j] * wB; }
        }
#pragma unroll
        for (int l = 0; l < 16; ++l) { RED[(kq * 34 + c) * 16 + l] = accA[l]; if (c < 2) RED[(kq * 34 + 32 + c) * 16 + l] = accB[l]; }
        __syncthreads();
        for (int o = tid; o < 34 * 16; o += 512) { const int cc = o >> 4, l = o & 15; float s = 0.f;
#pragma unroll
            for (int q = 0; q < 16; ++q) s += RED[(q * 34 + cc) * 16 + l];
            P[(size_t)(MROW + l) * LDP + n0 + cc] = (bf16_t)f2bf(s); }
        __syncthreads();
    }
}

struct LoraW { bf16x8 w[2][2], a[2][2], g[2][6]; };
__device__ __forceinline__ void lora_ldw(LoraW& F, const bf16_t* WDEC, const bf16_t* WA2, const bf16_t* WG2, int p, int fr, int fq) {
#pragma unroll
    for (int u = 0; u < 2; ++u) { const int n = 32 * p + 8 * (fr >> 2) + 4 * u + (fr & 3);
#pragma unroll
        for (int ks = 0; ks < 2; ++ks) { F.w[u][ks] = *(const bf16x8*)(WDEC + n * 64 + ks * 32 + fq * 8); F.a[u][ks] = *(const bf16x8*)(WA2 + n * 64 + ks * 32 + fq * 8); }
#pragma unroll
        for (int ks = 0; ks < 6; ++ks) F.g[u][ks] = *(const bf16x8*)(WG2 + n * 192 + ks * 32 + fq * 8); }
}
__device__ __forceinline__ void phase_lora(const Args& a, LAS unsigned char* lds) {
    const int tid = tidx(), wave = tid >> 6, lane = tid & 63, fr = lane & 15, fq = lane >> 4;
    const bf16_t* P = (const bf16_t*)(a.ws + WS_P);
    const bf16_t* WDEC = (const bf16_t*)(a.ws + WS_WDEC); const bf16_t* WA2 = (const bf16_t*)(a.ws + WS_WA2); const bf16_t* WG2 = (const bf16_t*)(a.ws + WS_WG2);
    bf16_t* WLIN = (bf16_t*)(a.ws + WS_LORA); bf16_t* ALIN = (bf16_t*)(a.ws + WS_LORA + LSLOT); bf16_t* GLIN = (bf16_t*)(a.ws + WS_LORA + 2 * LSLOT);
    LAS bf16_t* Xw = (LAS bf16_t*)lds; LAS bf16_t* Xa = Xw + 128 * 72; LAS bf16_t* Xg = Xa + 128 * 72;
    const float* mu_w = a.in[11]; const float* mu_a = a.in[12]; const float* mu_g = a.in[13];
    for (int tile = blockIdx.x; tile <= TR / 128; tile += gridDim.x) {
        const bool meta = (tile == TR / 128);
        { const int rr = tid >> 2, qd = tid & 3;
          int t, tp;
          if (!meta) { t = tile * 128 + rr; tp = (t & (SEQ - 1)) ? t - 1 : MROW + NMETA - 1; }
          else { t = MROW + (rr & 15); tp = (rr & 15) ? t - 1 : -1; }
          const bool hp = tp >= 0;
          const bf16_t* cur = P + (size_t)t * LDP; const bf16_t* prv = P + (size_t)(hp ? tp : t) * LDP;
#pragma unroll
          for (int hf = 0; hf < 2; ++hf) { const int c = qd * 16 + hf * 8;
              { const u32x4 vc = *(const u32x4*)(cur + C_RW + c); u32x4 vp = (u32x4){0u, 0u, 0u, 0u}; if (hp) vp = *(const u32x4*)(prv + C_RW + c);
                float z[8]; const unsigned wc_[4] = {vc.x, vc.y, vc.z, vc.w}, wp_[4] = {vp.x, vp.y, vp.z, vp.w};
#pragma unroll
                for (int j = 0; j < 4; ++j) { const float c0 = bf_lo(wc_[j]), c1 = bf_hi(wc_[j]), p0 = bf_lo(wp_[j]), p1 = bf_hi(wp_[j]);
                    z[2 * j] = tanhf_(c0 + (p0 - c0) * mu_w[c + 2 * j]); z[2 * j + 1] = tanhf_(c1 + (p1 - c1) * mu_w[c + 2 * j + 1]); }
                *(LAS u32x4*)(Xw + rr * 72 + c) = (u32x4){pk2(z[0], z[1]), pk2(z[2], z[3]), pk2(z[4], z[5]), pk2(z[6], z[7])}; }
              { const u32x4 vc = *(const u32x4*)(cur + C_RA + c); u32x4 vp = (u32x4){0u, 0u, 0u, 0u}; if (hp) vp = *(const u32x4*)(prv + C_RA + c);
                float z[8]; const unsigned wc_[4] = {vc.x, vc.y, vc.z, vc.w}, wp_[4] = {vp.x, vp.y, vp.z, vp.w};
#pragma unroll
                for (int j = 0; j < 4; ++j) { const float c0 = bf_lo(wc_[j]), c1 = bf_hi(wc_[j]), p0 = bf_lo(wp_[j]), p1 = bf_hi(wp_[j]);
                    z[2 * j] = c0 + (p0 - c0) * mu_a[c + 2 * j]; z[2 * j + 1] = c1 + (p1 - c1) * mu_a[c + 2 * j + 1]; }
                *(LAS u32x4*)(Xa + rr * 72 + c) = (u32x4){pk2(z[0], z[1]), pk2(z[2], z[3]), pk2(z[4], z[5]), pk2(z[6], z[7])}; } }
#pragma unroll
          for (int ch = 0; ch < 5; ++ch) { const int c = qd * 40 + ch * 8;
              const u32x4 vc = *(const u32x4*)(cur + C_RG + c); u32x4 vp = (u32x4){0u, 0u, 0u, 0u}; if (hp) vp = *(const u32x4*)(prv + C_RG + c);
              float z[8]; const unsigned wc_[4] = {vc.x, vc.y, vc.z, vc.w}, wp_[4] = {vp.x, vp.y, vp.z, vp.w};
#pragma unroll
              for (int j = 0; j < 4; ++j) { const float c0 = bf_lo(wc_[j]), c1 = bf_hi(wc_[j]), p0 = bf_lo(wp_[j]), p1 = bf_hi(wp_[j]);
                  z[2 * j] = sigmoidf_(c0 + (p0 - c0) * mu_g[c + 2 * j]); z[2 * j + 1] = sigmoidf_(c1 + (p1 - c1) * mu_g[c + 2 * j + 1]); }
              *(LAS u32x4*)(Xg + rr * 200 + c) = (u32x4){pk2(z[0], z[1]), pk2(z[2], z[3]), pk2(z[4], z[5]), pk2(z[6], z[7])}; }
          *(LAS u32x4*)(Xg + rr * 200 + 160 + qd * 8) = (u32x4){0u, 0u, 0u, 0u};
        }
        __syncthreads();
        const int ngrp = meta ? 1 : 8;
        for (int pp = 0; pp < 4; ++pp) { const int p = wave * 4 + pp;
            LoraW F; lora_ldw(F, WDEC, WA2, WG2, p, fr, fq);
            for (int mg = 0; mg < ngrp; ++mg) { const int m0 = mg * 16;
                f32x4 cw[2], ca[2], cg[2];
#pragma unroll
                for (int u = 0; u < 2; ++u) { cw[u] = (f32x4){0.f, 0.f, 0.f, 0.f}; ca[u] = cw[u]; cg[u] = cw[u]; }
#pragma unroll
                for (int ks = 0; ks < 2; ++ks) { const bf16x8 xw = *(const LAS bf16x8*)(Xw + (m0 + fr) * 72 + ks * 32 + fq * 8), xa = *(const LAS bf16x8*)(Xa + (m0 + fr) * 72 + ks * 32 + fq * 8);
#pragma unroll
                    for (int u = 0; u < 2; ++u) { cw[u] = __builtin_amdgcn_mfma_f32_16x16x32_bf16(F.w[u][ks], xw, cw[u], 0, 0, 0); ca[u] = __builtin_amdgcn_mfma_f32_16x16x32_bf16(F.a[u][ks], xa, ca[u], 0, 0, 0); } }
#pragma unroll
                for (int ks = 0; ks < 6; ++ks) { const bf16x8 xg = *(const LAS bf16x8*)(Xg + (m0 + fr) * 200 + ks * 32 + fq * 8);
#pragma unroll
                    for (int u = 0; u < 2; ++u) cg[u] = __builtin_amdgcn_mfma_f32_16x16x32_bf16(F.g[u][ks], xg, cg[u], 0, 0, 0); }
                const size_t orow = (size_t)((meta ? MROW : tile * 128) + m0 + fr) * D; const int oc = 32 * p + 8 * fq;
                *(u32x4*)(WLIN + orow + oc) = (u32x4){pk2(cw[0][0], cw[0][1]), pk2(cw[0][2], cw[0][3]), pk2(cw[1][0], cw[1][1]), pk2(cw[1][2], cw[1][3])};
                *(u32x4*)(ALIN + orow + oc) = (u32x4){pk2(ca[0][0], ca[0][1]), pk2(ca[0][2], ca[0][3]), pk2(ca[1][0], ca[1][1]), pk2(ca[1][2], ca[1][3])};
                *(u32x4*)(GLIN + orow + oc) = (u32x4){pk2(cg[0][0], cg[0][1]), pk2(cg[0][2], cg[0][3]), pk2(cg[1][0], cg[1][1]), pk2(cg[1][2], cg[1][3])};
            }
        }
        __syncthreads();
    }
}

__device__ __forceinline__ int swzf(int row) { return ((row >> 1) & 7) ^ ((row >> 4) & 7); }
__device__ __forceinline__ int swz(int row, int col) { return row * 64 + ((((col >> 3) ^ swzf(row)) << 3) | (col & 7)); }
__device__ __forceinline__ bf16x8 ldfrag(const LAS bf16_t* M, int row, int kchunk) { return *(const LAS bf16x8*)(M + row * 64 + ((kchunk ^ swzf(row)) << 3)); }
__device__ __forceinline__ float frcp(float x) { return __builtin_amdgcn_rcpf(x); }
struct FragOff { int o0, o1; };
__device__ __forceinline__ FragOff mkfo(int T, int fr, int X) { FragOff f; f.o0 = T * 1024 + fr * 64 + (((T ^ X) & 7) << 3); f.o1 = f.o0 ^ 32; return f; }
#define LDF(M, fo, ks) (*(const LAS bf16x8*)((M) + ((ks) ? (fo).o1 : (fo).o0)))
#define LDF2(M, fo, ks) (*(const LAS bf16x8*)((M) + ((ks) >> 1) * 4096 + (((ks) & 1) ? (fo).o1 : (fo).o0)))

__device__ __forceinline__ void rwkv_item(const Args& a, LAS unsigned char* lds, int item) {
    const int tid = tidx(), wave = __builtin_amdgcn_readfirstlane(tid >> 6), lane = tid & 63, fr = lane & 15, fq = lane >> 4;
    const int b = item >> 4, h = item & 15;
    LAS bf16_t* ZA = (LAS bf16_t*)lds;
    LAS bf16_t* ZR = ZA + 4096;
    LAS bf16_t* XBm = ZR + 4096;
    LAS bf16_t* XK = XBm + 4096;
    LAS bf16_t* BTt = XK + 4096;
    LAS bf16_t* KTt = BTt + 4096;
    LAS bf16_t* VcT = KTt + 4096;
    LAS bf16_t* MakT = VcT + 4096;
    LAS bf16_t* NbrT = MakT + 4096;
    LAS bf16_t* NkrT = NbrT + 4096;
    LAS bf16_t* TIv = NkrT + 4096;
    LAS bf16_t* S0b = TIv + 4096;
    LAS bf16_t* U0b = S0b + 4096;
    LAS bf16_t* Ub = U0b + 4096;
    LAS float* CW = (LAS float*)(lds + 14 * 8192);
    LAS float* PTs = CW + 4096;
    LAS float* WCv = PTs + 512;
    LAS float* CST = WCv + 64;
    LAS bf16_t* PAb = (LAS bf16_t*)(CST + 640);
    LAS bf16_t* MA = U0b; LAS bf16_t* MAT = Ub; LAS bf16_t* MB = (LAS bf16_t*)CW; LAS bf16_t* MBT = MB + 4096;
    const bf16_t* P = (const bf16_t*)(a.ws + WS_P);
    const bf16_t* WLIN = (const bf16_t*)(a.ws + WS_LORA); const bf16_t* ALIN = (const bf16_t*)(a.ws + WS_LORA + LSLOT); const bf16_t* GLIN = (const bf16_t*)(a.ws + WS_LORA + 2 * LSLOT);
    bf16_t* A12 = (bf16_t*)(a.ws + WS_R5);
    const int ptt = tid >> 3, c8 = (tid & 7) * 8, col = h * 64 + c8;
    if (tid < 64) { const int cc = h * 64 + tid;
        CST[tid] = a.in[8][cc]; CST[64 + tid] = a.in[9][cc]; CST[128 + tid] = a.in[10][cc]; CST[192 + tid] = a.in[15][cc]; CST[256 + tid] = a.in[17][cc];
        CST[320 + tid] = a.in[19][cc]; CST[384 + tid] = a.in[20][cc]; CST[448 + tid] = a.in[21][cc]; CST[512 + tid] = a.in[22][cc]; CST[576 + tid] = a.in[23][cc]; }
#define CSTV(arr, idx) float arr[8]; { const f32x4 c0_ = *(const LAS f32x4*)(CST + (idx) * 64 + c8), c1_ = *(const LAS f32x4*)(CST + (idx) * 64 + c8 + 4); \
        arr[0] = c0_[0]; arr[1] = c0_[1]; arr[2] = c0_[2]; arr[3] = c0_[3]; arr[4] = c1_[0]; arr[5] = c1_[1]; arr[6] = c1_[2]; arr[7] = c1_[3]; }
    f32x4 st[2]; st[0] = (f32x4){0.f, 0.f, 0.f, 0.f}; st[1] = st[0];
    for (int i = tid; i < 2048; i += 512) ((LAS unsigned*)S0b)[i] = 0u;
    for (int i = tid; i < 4 * 2048; i += 512) ((LAS unsigned*)MakT)[i] = 0u;
    const int ii = wave >> 1, tb = 2 * (wave & 1);
    const u32x4 z4 = (u32x4){0u, 0u, 0u, 0u};
    u32x4 Lr, Lk, Lv, Lrp, Lkp, Lvp, Lw, La, Lg;
#define RW_LOAD(nn) do { const int l_ = (nn) * 64 + ptt; const bool v_ = l_ < L; const bool hp_ = v_ && l_ > 0; \
        Lr = z4; Lk = z4; Lv = z4; Lrp = z4; Lkp = z4; Lvp = z4; Lw = z4; La = z4; Lg = z4; \
        if (v_) { const size_t r_ = (size_t)prow(b, l_); const bf16_t* pc = P + r_ * LDP + col; const size_t lo = r_ * D + col; \
            Lr = *(const u32x4*)(pc + C_RR); Lk = *(const u32x4*)(pc + C_RK); Lv = *(const u32x4*)(pc + C_RV); \
            Lw = *(const u32x4*)(WLIN + lo); La = *(const u32x4*)(ALIN + lo); Lg = *(const u32x4*)(GLIN + lo); } \
        if (hp_) { const bf16_t* pp = P + (size_t)prow(b, l_ - 1) * LDP + col; Lrp = *(const u32x4*)(pp + C_RR); Lkp = *(const u32x4*)(pp + C_RK); Lvp = *(const u32x4*)(pp + C_RV); } } while (0)
    RW_LOAD(0);
    __syncthreads();
#define LDS_BAR() do { asm volatile("s_waitcnt lgkmcnt(0)" ::: "memory"); __builtin_amdgcn_s_barrier(); asm volatile("" ::: "memory"); } while (0)
#define CVT1(x) ((bf16_t)f2bf(x))
#define CVT4(v0, v1, v2, v3) ((u32x2){pk2((v0), (v1)), pk2((v2), (v3))})
    const int tid_outer = tid;
    for (int n = 0; n < 65; ++n) {
        int tid = tid_outer; asm volatile("" : "+v"(tid));
        const int lane = tid & 63, fr = lane & 15, fq = lane >> 4, ptt = tid >> 3, c8 = (tid & 7) * 8, tk = lane >> 3;
        const int fX = (fq ^ (fr >> 1)) & 7; const FragOff fI = mkfo(ii, fr, fX); const FragOff fT[2] = {mkfo(tb, fr, fX), mkfo(tb + 1, fr, fX)};
        const int l = n * 64 + ptt; const bool valid = l < L;
        float r[8], km[8], v[8], av[8], bv[8], g[8], lw[8], cwv[8], bonus;
        {
            const unsigned wr_[4] = {Lr.x, Lr.y, Lr.z, Lr.w}, wrp[4] = {Lrp.x, Lrp.y, Lrp.z, Lrp.w}, wk_[4] = {Lk.x, Lk.y, Lk.z, Lk.w}, wkp[4] = {Lkp.x, Lkp.y, Lkp.z, Lkp.w};
            const unsigned wv_[4] = {Lv.x, Lv.y, Lv.z, Lv.w}, wvp[4] = {Lvp.x, Lvp.y, Lvp.z, Lvp.w}, ww_[4] = {Lw.x, Lw.y, Lw.z, Lw.w}, wa_[4] = {La.x, La.y, La.z, La.w}, wg_[4] = {Lg.x, Lg.y, Lg.z, Lg.w};
            float k[8], asg[8], kkv[8]; float nrm = 0.f;
            CSTV(mur, 0) CSTV(muk, 1) CSTV(muv, 2) CSTV(bdec, 3) CSTV(ba, 4) CSTV(kkc, 5)
#pragma unroll
            for (int e = 0; e < 8; ++e) { const int q = e >> 1; const bool hi_ = e & 1;
                const float rc = hi_ ? bf_hi(wr_[q]) : bf_lo(wr_[q]), rp = hi_ ? bf_hi(wrp[q]) : bf_lo(wrp[q]);
                const float kc = hi_ ? bf_hi(wk_[q]) : bf_lo(wk_[q]), kp = hi_ ? bf_hi(wkp[q]) : bf_lo(wkp[q]);
                const float vc = hi_ ? bf_hi(wv_[q]) : bf_lo(wv_[q]), vp = hi_ ? bf_hi(wvp[q]) : bf_lo(wvp[q]);
                const float wl = hi_ ? bf_hi(ww_[q]) : bf_lo(ww_[q]), al = hi_ ? bf_hi(wa_[q]) : bf_lo(wa_[q]);
                g[e] = hi_ ? bf_hi(wg_[q]) : bf_lo(wg_[q]);
                r[e] = rc + (rp - rc) * mur[e]; k[e] = kc + (kp - kc) * muk[e]; v[e] = vc + (vp - vc) * muv[e];
                lw[e] = valid ? -0.6065306597126334f * frcp(1.0f + __expf(-(bdec[e] + wl))) : 0.f;
                asg[e] = frcp(1.0f + __expf(-(ba[e] + al)));
                kkv[e] = k[e] * kkc[e]; nrm += kkv[e] * kkv[e]; }
            nrm = red8(nrm);
            const float inv = rsqrtf(fmaxf(nrm, 1e-24f));
            float bn = 0.f;
            CSTV(kac, 6) CSTV(rkc, 7)
#pragma unroll
            for (int e = 0; e < 8; ++e) { const float kkn = kkv[e] * inv; km[e] = k[e] * (1.0f + (asg[e] - 1.0f) * kac[e]); av[e] = -kkn; bv[e] = kkn * asg[e]; bn += r[e] * km[e] * rkc[e]; }
            bonus = red8(bn);
#pragma unroll
            for (int e = 0; e < 8; ++e) { float x = lw[e];
                float y = __shfl_up(x, 8); x += (tk >= 1) ? y : 0.f;
                y = __shfl_up(x, 16); x += (tk >= 2) ? y : 0.f;
                y = __shfl_up(x, 32); x += (tk >= 4) ? y : 0.f;
                cwv[e] = x; }
            if (tk == 7) { *(LAS f32x4*)(PTs + wave * 64 + c8) = (f32x4){cwv[0], cwv[1], cwv[2], cwv[3]}; *(LAS f32x4*)(PTs + wave * 64 + c8 + 4) = (f32x4){cwv[4], cwv[5], cwv[6], cwv[7]}; }
        }
#pragma unroll
        for (int e = 0; e < 8; ++e) VcT[swz(c8 + e, ptt)] = CVT1(v[e]);
        LDS_BAR();
        { for (int p = 0; p < wave; ++p) { const f32x4 p0 = *(const LAS f32x4*)(PTs + p * 64 + c8), p1 = *(const LAS f32x4*)(PTs + p * 64 + c8 + 4);
#pragma unroll
              for (int e = 0; e < 4; ++e) { cwv[e] += p0[e]; cwv[4 + e] += p1[e]; } }
          float za[8], zr[8], xb[8], xk[8];
#pragma unroll
          for (int e = 0; e < 8; ++e) { const float ew = __expf(cwv[e]), ei = frcp(ew), ep = __expf(cwv[e] - lw[e]);
              za[e] = av[e] * ep; zr[e] = r[e] * ew; xb[e] = bv[e] * ei; xk[e] = km[e] * ei;
              if (ptt == 63) WCv[c8 + e] = ew; }
          const int so = swz(ptt, c8);
          { const u32x2 a0 = CVT4(za[0], za[1], za[2], za[3]), a1 = CVT4(za[4], za[5], za[6], za[7]); *(LAS u32x4*)(ZA + so) = (u32x4){a0.x, a0.y, a1.x, a1.y}; }
          { const u32x2 a0 = CVT4(zr[0], zr[1], zr[2], zr[3]), a1 = CVT4(zr[4], zr[5], zr[6], zr[7]); *(LAS u32x4*)(ZR + so) = (u32x4){a0.x, a0.y, a1.x, a1.y}; }
          { const u32x2 a0 = CVT4(xb[0], xb[1], xb[2], xb[3]), a1 = CVT4(xb[4], xb[5], xb[6], xb[7]); *(LAS u32x4*)(XBm + so) = (u32x4){a0.x, a0.y, a1.x, a1.y}; }
          { const u32x2 a0 = CVT4(xk[0], xk[1], xk[2], xk[3]), a1 = CVT4(xk[4], xk[5], xk[6], xk[7]); *(LAS u32x4*)(XK + so) = (u32x4){a0.x, a0.y, a1.x, a1.y}; }
#pragma unroll
          for (int e = 0; e < 8; ++e) { BTt[swz(c8 + e, ptt)] = CVT1(xb[e]); KTt[swz(c8 + e, ptt)] = CVT1(xk[e]); } }
        if (n + 1 < 65) RW_LOAD(n + 1);
        LDS_BAR();
        f32x4 u0[2], cy[2];
        if (wave == 0 || wave == 4) {
            const int bb = wave >> 2, kx = bb << 5, hsel = fq >> 1;
            const FragOff fB[2] = {mkfo(2 * bb, fr, fX), mkfo(2 * bb + 1, fr, fX)};
            const bf16x8 zf = (bf16x8){0, 0, 0, 0, 0, 0, 0, 0};
#define HALF(v, d) ((hsel == (d)) ? (v) : zf)
#define BFR(Mx, e_) (*(const LAS bf16x8*)((Mx) + (fB[e_].o0 ^ kx)))
#define WL_FENCE() asm volatile("s_waitcnt lgkmcnt(0)" ::: "memory")
            f32x4 pt[2];
            {   bf16x8 za[2][2], xb[2][2];
#pragma unroll
                for (int e_ = 0; e_ < 2; ++e_)
#pragma unroll
                    for (int ks = 0; ks < 2; ++ks) { za[e_][ks] = LDF(ZA, fB[e_], ks); xb[e_][ks] = LDF(XBm, fB[e_], ks); }
#pragma unroll
                for (int d = 0; d < 2; ++d) { f32x4 c = (f32x4){0.f, 0.f, 0.f, 0.f};
#pragma unroll
                    for (int ks = 0; ks < 2; ++ks) c = __builtin_amdgcn_mfma_f32_16x16x32_bf16(za[d][ks], xb[d][ks], c, 0, 0, 0);
                    const int s = (2 * bb + d) * 16 + fr, t0 = (2 * bb + d) * 16 + 4 * fq; float m[4];
#pragma unroll
                    for (int r4 = 0; r4 < 4; ++r4) { m[r4] = (s < t0 + r4) ? c[r4] : 0.f; c[r4] = m[r4] + ((s == t0 + r4) ? 1.f : 0.f); }
                    pt[d] = c;
                    *(LAS u32x2*)(MA + swz(s, t0)) = CVT4(m[0], m[1], m[2], m[3]);
#pragma unroll
                    for (int r4 = 0; r4 < 4; ++r4) MAT[swz(t0 + r4, s)] = CVT1(m[r4]);
                    *(LAS u32x2*)(TIv + swz(s, t0)) = CVT4(c[0], c[1], c[2], c[3]); }
                {   f32x4 c = (f32x4){0.f, 0.f, 0.f, 0.f};
#pragma unroll
                    for (int ks = 0; ks < 2; ++ks) c = __builtin_amdgcn_mfma_f32_16x16x32_bf16(za[1][ks], xb[0][ks], c, 0, 0, 0);
                    *(LAS u32x2*)(MA + swz(2 * bb * 16 + fr, (2 * bb + 1) * 16 + 4 * fq)) = CVT4(c[0], c[1], c[2], c[3]); } }
#define INV_SQ(Mc, McT, Mn, MnT) do { _Pragma("unroll") for (int d = 0; d < 2; ++d) { \
                    const f32x4 q_ = __builtin_amdgcn_mfma_f32_16x16x32_bf16(HALF(BFR(Mc, d), d), HALF(BFR(McT, d), d), (f32x4){0.f, 0.f, 0.f, 0.f}, 0, 0, 0);     \
                    const int t_ = (2 * bb + d) * 16 + fr, s0_ = (2 * bb + d) * 16 + 4 * fq; \
                    *(LAS u32x2*)((MnT) + swz(t_, s0_)) = CVT4(q_[0], q_[1], q_[2], q_[3]); \
                    _Pragma("unroll") for (int r4 = 0; r4 < 4; ++r4) (Mn)[swz(s0_ + r4, t_)] = CVT1(q_[r4]); } } while (0)
#define INV_PU(McT, Pc, Pn) do { _Pragma("unroll") for (int d = 0; d < 2; ++d) { \
                    pt[d] = __builtin_amdgcn_mfma_f32_16x16x32_bf16(HALF(BFR(McT, d), d), HALF(BFR(Pc, d), d), pt[d], 0, 0, 0);                                   \
                    *(LAS u32x2*)((Pn) + swz((2 * bb + d) * 16 + fr, (2 * bb + d) * 16 + 4 * fq)) = CVT4(pt[d][0], pt[d][1], pt[d][2], pt[d][3]); } } while (0)
            WL_FENCE(); INV_SQ(MA, MAT, MB, MBT);
            WL_FENCE(); INV_PU(MBT, TIv, PAb); INV_SQ(MB, MBT, MA, MAT);
            WL_FENCE(); INV_PU(MAT, PAb, TIv); INV_SQ(MA, MAT, MB, MBT);
            WL_FENCE(); INV_PU(MBT, TIv, PAb);
#pragma unroll
            for (int d = 0; d < 2; ++d) {
#pragma unroll
                for (int r4 = 0; r4 < 4; ++r4) TIv[swz((2 * bb + d) * 16 + 4 * fq + r4, (2 * bb + d) * 16 + fr)] = CVT1(pt[d][r4]); }
            WL_FENCE();
            {
                const f32x4 c = __builtin_amdgcn_mfma_f32_16x16x32_bf16(HALF(BFR(MA, 0), 1), HALF(BFR(TIv, 1), 1), (f32x4){0.f, 0.f, 0.f, 0.f}, 0, 0, 0);
                *(LAS u32x2*)(PAb + swz((2 * bb + 1) * 16 + fr, 2 * bb * 16 + 4 * fq)) = CVT4(c[0], c[1], c[2], c[3]); }
            WL_FENCE();
            {
                const f32x4 c = __builtin_amdgcn_mfma_f32_16x16x32_bf16(HALF(BFR(PAb, 1), 0), HALF(BFR(PAb, 0), 0), (f32x4){0.f, 0.f, 0.f, 0.f}, 0, 0, 0);
#pragma unroll
                for (int r4 = 0; r4 < 4; ++r4) TIv[swz((2 * bb + 1) * 16 + 4 * fq + r4, 2 * bb * 16 + fr)] = CVT1(c[r4]);
                if (bb == 0) {
                    *(LAS u32x2*)(MBT + swz(fr, 32 + 16 + 4 * fq)) = CVT4(c[0], c[1], c[2], c[3]);
                    *(LAS u32x2*)(MBT + swz(fr, 32 + 4 * fq)) = CVT4(pt[0][0], pt[0][1], pt[0][2], pt[0][3]);
                    *(LAS u32x2*)(MBT + swz(16 + fr, 32 + 16 + 4 * fq)) = CVT4(pt[1][0], pt[1][1], pt[1][2], pt[1][3]);
                    *(LAS u32x2*)(MBT + swz(16 + fr, 32 + 4 * fq)) = (u32x2){0u, 0u}; } }
#undef INV_SQ
#undef INV_PU
#undef WL_FENCE
#undef HALF
#undef BFR
        } else {
            const int wi = wave - 1 - (wave > 4 ? 1 : 0);
            for (int Q = wi; Q < 34; Q += 6) {
                if (Q < 30) { const int mat = Q / 10, q10 = Q - mat * 10, ti = (q10 >= 6) ? 3 : ((q10 >= 3) ? 2 : ((q10 >= 1) ? 1 : 0)), si = q10 - (ti * (ti + 1)) / 2;
                    const LAS bf16_t* Xm = (mat == 1) ? XBm : XK; const LAS bf16_t* Zm = (mat == 0) ? ZA : ZR; LAS bf16_t* Om = (mat == 0) ? MakT : ((mat == 1) ? NbrT : NkrT);
                    f32x4 c = (f32x4){0.f, 0.f, 0.f, 0.f}; const FragOff fS_ = mkfo(si, fr, fX), fT_ = mkfo(ti, fr, fX);
#pragma unroll
                    for (int ks = 0; ks < 2; ++ks) c = __builtin_amdgcn_mfma_f32_16x16x32_bf16(LDF(Xm, fS_, ks), LDF(Zm, fT_, ks), c, 0, 0, 0);
                    const int t = ti * 16 + fr, s0 = si * 16 + 4 * fq; float o[4];
#pragma unroll
                    for (int r4 = 0; r4 < 4; ++r4) { const int s = s0 + r4; const bool keep = (mat == 0) ? (s < t) : (s <= t); o[r4] = keep ? c[r4] : 0.f; }
                    *(LAS u32x2*)(Om + swz(t, s0)) = CVT4(o[0], o[1], o[2], o[3]); }
                else { const int otl = 2 + ((Q - 30) >> 1), osl = (Q - 30) & 1; f32x4 c = (f32x4){0.f, 0.f, 0.f, 0.f}; const FragOff fOT = mkfo(otl, fr, fX), fOS = mkfo(osl, fr, fX);
#pragma unroll
                    for (int ks = 0; ks < 2; ++ks) c = __builtin_amdgcn_mfma_f32_16x16x32_bf16(LDF(ZA, fOT, ks), LDF(XBm, fOS, ks), c, 0, 0, 0);
                    *(LAS u32x2*)(MA + swz(osl * 16 + fr, otl * 16 + 4 * fq)) = CVT4(c[0], c[1], c[2], c[3]); } } }
        LDS_BAR();
#pragma unroll
        for (int u = 0; u < 2; ++u) { f32x4 c = (f32x4){0.f, 0.f, 0.f, 0.f};
#pragma unroll
            for (int ks = 0; ks < 2; ++ks) c = __builtin_amdgcn_mfma_f32_16x16x32_bf16(LDF(ZA, fT[u], ks), LDF(S0b, fI, ks), c, 0, 0, 0);
#pragma unroll
            for (int ks = 0; ks < 2; ++ks) c = __builtin_amdgcn_mfma_f32_16x16x32_bf16(LDF(MakT, fT[u], ks), LDF(VcT, fI, ks), c, 0, 0, 0);
            u0[u] = c; }
#pragma unroll
        for (int u = 0; u < 2; ++u) { f32x4 c = (f32x4){0.f, 0.f, 0.f, 0.f};
#pragma unroll
            for (int ks = 0; ks < 2; ++ks) c = __builtin_amdgcn_mfma_f32_16x16x32_bf16(LDF(S0b, fI, ks), LDF(ZR, fT[u], ks), c, 0, 0, 0);
#pragma unroll
            for (int ks = 0; ks < 2; ++ks) c = __builtin_amdgcn_mfma_f32_16x16x32_bf16(LDF(VcT, fI, ks), LDF(NkrT, fT[u], ks), c, 0, 0, 0);
            cy[u] = c; }
#pragma unroll
        for (int u = 0; u < 2; ++u) {
#pragma unroll
            for (int ks = 0; ks < 2; ++ks) st[u] = __builtin_amdgcn_mfma_f32_16x16x32_bf16(LDF(VcT, fI, ks), LDF(KTt, fT[u], ks), st[u], 0, 0, 0); }
        if (wave < 4) { const int xsl = wave >> 1, xtl = 2 + (wave & 1);
            const f32x4 c = __builtin_amdgcn_mfma_f32_16x16x32_bf16(LDF(MA, mkfo(xsl, fr, fX), 1), LDF(TIv, mkfo(xtl, fr, fX), 1), (f32x4){0.f, 0.f, 0.f, 0.f}, 0, 0, 0);
            *(LAS u32x2*)(MB + swz(xtl * 16 + fr, xsl * 16 + 4 * fq)) = CVT4(c[0], c[1], c[2], c[3]); }
        LDS_BAR();
        if (wave < 4) { const int ntl = 2 + (wave >> 1), nsl = wave & 1;
            const f32x4 c = __builtin_amdgcn_mfma_f32_16x16x32_bf16(LDF(MB, mkfo(ntl, fr, fX), 0), LDF(MBT, mkfo(nsl, fr, fX), 1), (f32x4){0.f, 0.f, 0.f, 0.f}, 0, 0, 0);
#pragma unroll
            for (int r4 = 0; r4 < 4; ++r4) TIv[swz(ntl * 16 + 4 * fq + r4, nsl * 16 + fr)] = CVT1(c[r4]); }
#pragma unroll
        for (int u = 0; u < 2; ++u) *(LAS u32x2*)(U0b + swz(ii * 16 + fr, (tb + u) * 16 + 4 * fq)) = CVT4(u0[u][0], u0[u][1], u0[u][2], u0[u][3]);
        LDS_BAR();
#pragma unroll
        for (int u = 0; u < 2; ++u) { const int ti = tb + u; f32x4 c = (f32x4){0.f, 0.f, 0.f, 0.f};
#pragma unroll
            for (int ks = 0; ks < 2; ++ks) c = __builtin_amdgcn_mfma_f32_16x16x32_bf16(LDF(TIv, fT[u], ks), LDF(U0b, fI, ks), c, 0, 0, 0);
            *(LAS u32x2*)(Ub + swz(ii * 16 + fr, ti * 16 + 4 * fq)) = CVT4(c[0], c[1], c[2], c[3]); }
        LDS_BAR();
        LAS float* YB = CW;
#pragma unroll
        for (int u = 0; u < 2; ++u) { const int ti = tb + u;
#pragma unroll
            for (int ks = 0; ks < 2; ++ks) cy[u] = __builtin_amdgcn_mfma_f32_16x16x32_bf16(LDF(Ub, fI, ks), LDF(NbrT, fT[u], ks), cy[u], 0, 0, 0);
            *(LAS f32x4*)(YB + (ti * 16 + fr) * 64 + ii * 16 + 4 * fq) = cy[u]; }
#pragma unroll
        for (int u = 0; u < 2; ++u) { const int jt = tb + u;
#pragma unroll
            for (int ks = 0; ks < 2; ++ks) st[u] = __builtin_amdgcn_mfma_f32_16x16x32_bf16(LDF(Ub, fI, ks), LDF(BTt, fT[u], ks), st[u], 0, 0, 0);
            st[u] = st[u] * WCv[jt * 16 + fr];
#pragma unroll
            for (int r4 = 0; r4 < 4; ++r4) S0b[swz(ii * 16 + 4 * fq + r4, jt * 16 + fr)] = CVT1(st[u][r4]); }
        LDS_BAR();
        { const f32x4 y0 = *(const LAS f32x4*)(YB + ptt * 64 + c8), y1 = *(const LAS f32x4*)(YB + ptt * 64 + c8 + 4);
          float y[8];
#pragma unroll
          for (int e = 0; e < 4; ++e) { y[e] = y0[e]; y[4 + e] = y1[e]; }
          float sm = 0.f;
#pragma unroll
          for (int e = 0; e < 8; ++e) sm += y[e];
          const float mean = red8(sm) * (1.0f / 64.0f); float sq = 0.f;
#pragma unroll
          for (int e = 0; e < 8; ++e) { y[e] -= mean; sq += y[e] * y[e]; }
          const float rstd = rsqrtf(red8(sq) * (1.0f / 64.0f) + 64e-5f);
          CSTV(lng, 8) CSTV(lnb, 9)
          float o[8];
#pragma unroll
          for (int e = 0; e < 8; ++e) o[e] = (y[e] * rstd * lng[e] + lnb[e] + bonus * v[e]) * g[e];
          if (l >= NMETA && l < L) { const u32x2 a0 = CVT4(o[0], o[1], o[2], o[3]), a1 = CVT4(o[4], o[5], o[6], o[7]);
              *(u32x4*)(A12 + ((size_t)b * SEQ + (l - NMETA)) * 2048 + 1024 + col) = (u32x4){a0.x, a0.y, a1.x, a1.y}; } }
    }
    __syncthreads();
#undef LDS_BAR
#undef CVT1
#undef CVT4
#undef CSTV
#undef RW_LOAD

}

__device__ __forceinline__ void gla_item(const Args& a, LAS unsigned char* lds, int item) {
    const int tid0 = tidx(), wave = __builtin_amdgcn_readfirstlane(tid0 >> 6);
    const int b = item >> 4, h = (item >> 2) & 3, s = item & 3;
    LAS float* BL0 = (LAS float*)lds;
    LAS bf16_t* QT = (LAS bf16_t*)(BL0 + 128);
    LAS bf16_t* KT = QT + 8192;
    LAS bf16_t* QS0 = KT + 8192;
    LAS bf16_t* KDT = QS0 + 16384;
    LAS bf16_t* VT0 = KDT + 8192;
    LAS bf16_t* AM = VT0 + 8192;
    LAS bf16_t* STB0 = AM + 4096;
    bf16_t* P = (bf16_t*)(a.ws + WS_P);
    for (int i = tid0; i < 4096; i += 512) ((LAS unsigned*)STB0)[i] = 0u;
    const int lane0 = tid0 & 63, fr0 = lane0 & 15, fq0 = lane0 >> 4;
    bf16x8 w2f;
    { unsigned wv_[4] = {0u, 0u, 0u, 0u};
      if (fq0 < 2) {
#pragma unroll
          for (int j = 0; j < 4; ++j) wv_[j] = pk2(a.in[4][(8 * fq0 + 2 * j) * 512 + h * 128 + 16 * wave + fr0], a.in[4][(8 * fq0 + 2 * j + 1) * 512 + h * 128 + 16 * wave + fr0]); }
      w2f = __builtin_bit_cast(bf16x8, (u32x4){wv_[0], wv_[1], wv_[2], wv_[3]}); }
    const f32x4 b2v = *(const f32x4*)(a.in[5] + h * 128 + 16 * wave + 4 * fq0);
    f32x4 st[4];
#pragma unroll
    for (int dt = 0; dt < 4; ++dt) st[dt] = (f32x4){0.f, 0.f, 0.f, 0.f};
    const float qscale = 0.08838834764831845f;
    const u32x4 z4 = (u32x4){0u, 0u, 0u, 0u}; const u32x2 z2 = (u32x2){0u, 0u};
    u32x4 La[4], Lv; u32x2 Lq[4], Lk[4];
#define GL_LOAD(nn) do { Lv = z4; \
        _Pragma("unroll") for (int ti_ = 0; ti_ < 4; ++ti_) { const int l_ = (nn) * 64 - 48 + 16 * ti_ + fr0; La[ti_] = z4; Lq[ti_] = z2; Lk[ti_] = z2; \
            if (l_ >= 0) { const bf16_t* pr_ = P + (size_t)prow(b, l_) * LDP; if (fq0 < 2) La[ti_] = *(const u32x4*)(pr_ + C_GA + 8 * fq0); \
                Lq[ti_] = *(const u32x2*)(pr_ + C_GQ + h * 128 + 16 * wave + 4 * fq0); Lk[ti_] = *(const u32x2*)(pr_ + C_GK + h * 128 + 16 * wave + 4 * fq0); } } \
        { const int l_ = (nn) * 64 - 48 + (tid0 >> 3); if (l_ >= 0) Lv = *(const u32x4*)(P + (size_t)prow(b, l_) * LDP + C_GV + h * 256 + s * 64 + (tid0 & 7) * 8); } } while (0)
#define GL_BAR() do { asm volatile("s_waitcnt lgkmcnt(0)" ::: "memory"); __builtin_amdgcn_s_barrier(); asm volatile("" ::: "memory"); } while (0)
    GL_LOAD(0);
    __syncthreads();
    for (int n = 0; n < 65; ++n) {
        int tid = tid0; asm volatile("" : "+v"(tid));
        const int lane = tid & 63, fr = lane & 15, fq = lane >> 4, tl = tid >> 3;
        const int fX = (fq ^ (fr >> 1)) & 7; const FragOff fTi = mkfo(wave >> 1, fr, fX); const FragOff fJ[2] = {mkfo(2 * (wave & 1), fr, fX), mkfo(2 * (wave & 1) + 1, fr, fX)}; const FragOff fW = mkfo(wave, fr, fX);
        const int l0 = n * 64 - 48;
        LAS float* BL = BL0; LAS bf16_t* QS = QS0 + (n & 1) * 8192; LAS bf16_t* VT = VT0 + (n & 1) * 4096; LAS bf16_t* STBr = STB0 + (n & 1) * 8192; LAS bf16_t* STBw = STB0 + ((n + 1) & 1) * 8192;
        { f32x4 bt[4];
#pragma unroll
          for (int ti = 0; ti < 4; ++ti) { const bool valid = (l0 + 16 * ti + fr) >= 0;
              f32x4 x = __builtin_amdgcn_mfma_f32_16x16x32_bf16(w2f, __builtin_bit_cast(bf16x8, La[ti]), (f32x4){0.f, 0.f, 0.f, 0.f}, 0, 0, 0);
#pragma unroll
              for (int r = 0; r < 4; ++r) { const float xx = x[r] + b2v[r]; float gk = valid ? (fminf(xx, 0.f) - __logf(1.0f + __expf(-fabsf(xx)))) * (1.0f / 16.0f) : 0.f;
                  gk += dppf<0x111>(gk); gk += dppf<0x112>(gk); gk += dppf<0x114>(gk); gk += dppf<0x118>(gk);
                  x[r] = gk; }
              bt[ti] = x; }
          f32x4 bref, blast;
          { f32x4 run = (f32x4){0.f, 0.f, 0.f, 0.f};
#pragma unroll
            for (int ti = 0; ti < 4; ++ti) { f32x4 tot;
#pragma unroll
                for (int r = 0; r < 4; ++r) tot[r] = __shfl(bt[ti][r], 15, 16);
                bt[ti] = bt[ti] + run; run = run + tot; if (ti == 1) bref = run; }
            blast = run; }
          if (fr == 0) *(LAS f32x4*)(BL + 16 * wave + 4 * fq) = (f32x4){__expf(blast[0]), __expf(blast[1]), __expf(blast[2]), __expf(blast[3])};
          const int hf = wave >> 2, cq = (16 * wave + 4 * fq) & 63;
#pragma unroll
          for (int ti = 0; ti < 4; ++ti) { const int tt = 16 * ti + fr;
              const float qv[4] = {bf_lo(Lq[ti].x), bf_hi(Lq[ti].x), bf_lo(Lq[ti].y), bf_hi(Lq[ti].y)}, kv[4] = {bf_lo(Lk[ti].x), bf_hi(Lk[ti].x), bf_lo(Lk[ti].y), bf_hi(Lk[ti].y)};
              float qt[4], kt[4], qs[4];
#pragma unroll
              for (int r = 0; r < 4; ++r) { const float bb = bt[ti][r];
                  const float e1 = __expf(bb - bref[r]), e2 = __builtin_amdgcn_rcpf(e1), e3 = __expf(bb), e4 = __expf(blast[r] - bb);
                  qt[r] = qv[r] * qscale * e1; kt[r] = kv[r] * e2; qs[r] = qv[r] * qscale * e3;
                  KDT[swz(16 * wave + 4 * fq + r, tt)] = (bf16_t)f2bf(kv[r] * e4); }
              const int so = hf * 4096 + swz(tt, cq);
              *(LAS u32x2*)(QT + so) = (u32x2){pk2(qt[0], qt[1]), pk2(qt[2], qt[3])};
              *(LAS u32x2*)(KT + so) = (u32x2){pk2(kt[0], kt[1]), pk2(kt[2], kt[3])};
              *(LAS u32x2*)(QS + so) = (u32x2){pk2(qs[0], qs[1]), pk2(qs[2], qs[3])}; }
          const unsigned wv[4] = {Lv.x, Lv.y, Lv.z, Lv.w}; const int d8 = (tid & 7) * 8;
#pragma unroll
          for (int j = 0; j < 4; ++j) { VT[swz(d8 + 2 * j, tl)] = (bf16_t)(wv[j] & 0xffffu); VT[swz(d8 + 2 * j + 1, tl)] = (bf16_t)(wv[j] >> 16); } }
        if (n + 1 < 65) GL_LOAD(n + 1);
        GL_BAR();
        { const int ti = wave >> 1;
#pragma unroll
          for (int jj = 0; jj < 2; ++jj) { const int ji = 2 * (wave & 1) + jj; f32x4 c = (f32x4){0.f, 0.f, 0.f, 0.f};
              if (ji <= ti) {
#pragma unroll
                  for (int ks = 0; ks < 4; ++ks) c = __builtin_amdgcn_mfma_f32_16x16x32_bf16(LDF2(KT, fJ[jj], ks), LDF2(QT, fTi, ks), c, 0, 0, 0); }
              const int t = ti * 16 + fr, j0 = ji * 16 + 4 * fq;
              float o[4];
#pragma unroll
              for (int r = 0; r < 4; ++r) o[r] = (j0 + r <= t) ? c[r] : 0.f;
              *(LAS u32x2*)(AM + swz(t, j0)) = (u32x2){pk2(o[0], o[1]), pk2(o[2], o[3])}; } }
        GL_BAR();
        { const int ti = wave >> 1, l0t = l0 + ti * 16 + fr;
#pragma unroll
          for (int dd = 0; dd < 2; ++dd) { const int di = 2 * (wave & 1) + dd; f32x4 c = (f32x4){0.f, 0.f, 0.f, 0.f};
#pragma unroll
              for (int ks = 0; ks < 2; ++ks) c = __builtin_amdgcn_mfma_f32_16x16x32_bf16(LDF(VT, fJ[dd], ks), LDF(AM, fTi, ks), c, 0, 0, 0);
#pragma unroll
              for (int ks = 0; ks < 4; ++ks) c = __builtin_amdgcn_mfma_f32_16x16x32_bf16(LDF2(STBr, fJ[dd], ks), LDF2(QS, fTi, ks), c, 0, 0, 0);
              if (l0t >= NMETA && !(a.flags & 8)) *(u32x2*)(P + ((size_t)b * SEQ + (l0t - NMETA)) * LDP + C_GV + h * 256 + s * 64 + di * 16 + 4 * fq) = (u32x2){pk2(c[0], c[1]), pk2(c[2], c[3])}; } }
        { const f32x4 dec = *(const LAS f32x4*)(BL + wave * 16 + 4 * fq);
          bf16x8 af[2];
#pragma unroll
          for (int ks = 0; ks < 2; ++ks) af[ks] = LDF(KDT, fW, ks);
#pragma unroll
          for (int dt = 0; dt < 4; ++dt) { st[dt] = st[dt] * dec;
#pragma unroll
              for (int ks = 0; ks < 2; ++ks) st[dt] = __builtin_amdgcn_mfma_f32_16x16x32_bf16(af[ks], LDF(VT, mkfo(dt, fr, fX), ks), st[dt], 0, 0, 0);
              const int dk0 = wave * 16 + 4 * fq;
              *(LAS u32x2*)(STBw + (dk0 >> 6) * 4096 + swz(dt * 16 + fr, dk0 & 63)) = (u32x2){pk2(st[dt][0], st[dt][1]), pk2(st[dt][2], st[dt][3])}; } }
    }
    __syncthreads();
#undef GL_LOAD
#undef GL_BAR
}

__device__ __forceinline__ void phase_glanorm(const Args& a) {
    const int tid_ = tidx(), wave = tid_ >> 6, lane = tid_ & 63;
    const bf16_t* P = (const bf16_t*)(a.ws + WS_P); bf16_t* A12 = (bf16_t*)(a.ws + WS_R5);
    const int c0 = lane * 16;
    float gn[16];
#pragma unroll
    for (int j = 0; j < 16; ++j) gn[j] = a.in[6][(c0 & 255) + j];
    const int row_first = blockIdx.x * 8 + wave, row_step = gridDim.x * 8;
    u32x4 q[4], nq[4];
    { const bf16_t* pr = P + (size_t)(row_first < TR ? row_first : 0) * LDP; q[0] = *(const u32x4*)(pr + C_GV + c0); q[1] = *(const u32x4*)(pr + C_GV + c0 + 8); q[2] = *(const u32x4*)(pr + C_GR + c0); q[3] = *(const u32x4*)(pr + C_GR + c0 + 8);
#pragma unroll
      for (int j = 0; j < 4; ++j) nq[j] = q[j]; }
    for (int row = row_first; row < TR; row += row_step) {
        if (row + row_step < TR) { const bf16_t* pr = P + (size_t)(row + row_step) * LDP; nq[0] = *(const u32x4*)(pr + C_GV + c0); nq[1] = *(const u32x4*)(pr + C_GV + c0 + 8); nq[2] = *(const u32x4*)(pr + C_GR + c0); nq[3] = *(const u32x4*)(pr + C_GR + c0 + 8); }
        const u32x4 o0 = q[0], o1 = q[1], r0 = q[2], r1 = q[3];
#pragma unroll
        for (int j = 0; j < 4; ++j) q[j] = nq[j];
        const unsigned ow[8] = {o0.x, o0.y, o0.z, o0.w, o1.x, o1.y, o1.z, o1.w}, rw[8] = {r0.x, r0.y, r0.z, r0.w, r1.x, r1.y, r1.z, r1.w};
        float o[16], r[16]; float ss = 0.f;
#pragma unroll
        for (int j = 0; j < 8; ++j) { o[2 * j] = bf_lo(ow[j]); o[2 * j + 1] = bf_hi(ow[j]); r[2 * j] = bf_lo(rw[j]); r[2 * j + 1] = bf_hi(rw[j]); ss += o[2 * j] * o[2 * j] + o[2 * j + 1] * o[2 * j + 1]; }
        const float rstd = rsqrtf(red16(ss) * (1.0f / 256.0f) + EPS);
        float y[16];
#pragma unroll
        for (int j = 0; j < 16; ++j) y[j] = o[j] * rstd * gn[j] * (r[j] * sigmoidf_(r[j]));
        bf16_t* dst = A12 + (size_t)row * 2048 + c0;
        *(u32x4*)dst = (u32x4){pk2(y[0], y[1]), pk2(y[2], y[3]), pk2(y[4], y[5]), pk2(y[6], y[7])};
        *(u32x4*)(dst + 8) = (u32x4){pk2(y[8], y[9]), pk2(y[10], y[11]), pk2(y[12], y[13]), pk2(y[14], y[15])};
    }
}

__device__ __forceinline__ void phase_router(const Args& a, LAS unsigned char* lds) {
    const int tid = tidx(), wave = tid >> 6, lane = tid & 63, fr = lane & 15, fq = lane >> 4;
    constexpr int WPITCH = 2064;
    LAS int* HIST = (LAS int*)(lds + 64 * WPITCH);
    const float* gf = a.in[26]; const float* brt = a.in[28];
    const bf16_t* h2 = (const bf16_t*)(a.ws + WS_R5); bf16_t* U2 = (bf16_t*)(a.ws + WS_U2);
    int* tope = (int*)(a.ws + WS_TOPE); float* topc = (float*)(a.ws + WS_TOPC); int* cnt = (int*)(a.ws + WS_CNT);
    { const u32x4* src = (const u32x4*)(a.ws + WS_WRS);
      for (int i = tid; i < 64 * 128; i += 512) *(LAS u32x4*)(lds + (i >> 7) * WPITCH + (i & 127) * 16) = src[i]; }
    if (tid < 32) HIST[tid] = 0;
    __syncthreads();
    const int G = gridDim.x, RPB = (TR + G - 1) / G;
    const int r0 = blockIdx.x * RPB, r1 = (r0 + RPB < TR) ? (r0 + RPB) : TR;
    float bias[8];
#pragma unroll
    for (int j = 0; j < 8; ++j) bias[j] = brt[(j >> 2) * 16 + 4 * fq + (j & 3)];
    for (int rg = r0 + wave * 16; rg < r1; rg += 128) {
        const int row = rg + fr; const bool ok = row < r1;
        const u32x4* hp = (const u32x4*)(h2 + (size_t)(ok ? row : r0) * D) + fq;
        u32x4 hv[32];
#pragma unroll
        for (int s = 0; s < 32; ++s) hv[s] = hp[s * 4];
        float ss = 0.f;
#pragma unroll
        for (int s = 0; s < 32; ++s)
#pragma unroll
            for (int c = 0; c < 4; ++c) { const float lo = bf_lo(hv[s][c]), hi = bf_hi(hv[s][c]); ss += lo * lo; ss += hi * hi; }
        ss += __shfl_xor(ss, 16); ss += __shfl_xor(ss, 32);
        const float rs = rsqrtf(ss * (1.0f / D) + EPS);
#pragma unroll
        for (int s = 0; s < 32; ++s) asm volatile("" : "+v"(hv[s]));
        f32x4 acc0 = (f32x4){0.f, 0.f, 0.f, 0.f}, acc1 = acc0;
        const LAS unsigned char* wp = lds + fr * WPITCH + fq * 16;
#pragma unroll
        for (int s = 0; s < 32; ++s) {
            const bf16x8 tk = __builtin_bit_cast(bf16x8, hv[s]);
            const bf16x8 w0h = *(const LAS bf16x8*)(wp + s * 64), w1h = *(const LAS bf16x8*)(wp + 16 * WPITCH + s * 64);
            const bf16x8 w0l = *(const LAS bf16x8*)(wp + 32 * WPITCH + s * 64), w1l = *(const LAS bf16x8*)(wp + 48 * WPITCH + s * 64);
            acc0 = __builtin_amdgcn_mfma_f32_16x16x32_bf16(w0h, tk, acc0, 0, 0, 0); acc1 = __builtin_amdgcn_mfma_f32_16x16x32_bf16(w1h, tk, acc1, 0, 0, 0);
            acc0 = __builtin_amdgcn_mfma_f32_16x16x32_bf16(w0l, tk, acc0, 0, 0, 0); acc1 = __builtin_amdgcn_mfma_f32_16x16x32_bf16(w1l, tk, acc1, 0, 0, 0);
            if ((s & 3) == 3) asm volatile("" : "+v"(acc0), "+v"(acc1) :: "memory");
        }
#pragma unroll
        for (int s = 0; s < 32; ++s) asm volatile("" : "+v"(hv[s]));
        { u32x4* up = (u32x4*)(U2 + (size_t)row * D) + fq;
#pragma unroll
          for (int s = 0; s < 32; ++s) { u32x4 w;
#pragma unroll
              for (int c = 0; c < 4; ++c) w[c] = pk2(bf_lo(hv[s][c]) * rs, bf_hi(hv[s][c]) * rs);
              if (ok) up[s * 4] = w; } }
        float v[8];
#pragma unroll
        for (int j = 0; j < 4; ++j) { v[j] = acc0[j] * rs + bias[j]; v[4 + j] = acc1[j] * rs + bias[4 + j]; }
        int ti[4]; float tv[4];
#pragma unroll
        for (int kk = 0; kk < 4; ++kk) { float bv = v[0]; int be = 4 * fq;
#pragma unroll
            for (int j = 1; j < 8; ++j) { const int ej = (j >> 2) * 16 + 4 * fq + (j & 3); if (v[j] > bv) { bv = v[j]; be = ej; } }
#pragma unroll
            for (int o = 16; o < 64; o <<= 1) { const float ov = __shfl_xor(bv, o); const int oe = __shfl_xor(be, o); const bool g = (ov > bv) || (ov == bv && oe < be); bv = g ? ov : bv; be = g ? oe : be; }
            ti[kk] = be; tv[kk] = bv;
#pragma unroll
            for (int j = 0; j < 8; ++j) { const int ej = (j >> 2) * 16 + 4 * fq + (j & 3); v[j] = (ej == be) ? -3.0e38f : v[j]; } }
        if (fq == 0 && ok) {
            const float e1 = __expf(tv[1] - tv[0]), e2 = __expf(tv[2] - tv[0]), e3 = __expf(tv[3] - tv[0]); const float inv = 1.0f / (1.0f + e1 + e2 + e3);
            *(int4*)(tope + (size_t)row * 4) = make_int4(ti[0], ti[1], ti[2], ti[3]);
            *(float4*)(topc + (size_t)row * 4) = make_float4(inv, e1 * inv, e2 * inv, e3 * inv);
#pragma unroll
            for (int kk = 0; kk < 4; ++kk) __hip_atomic_fetch_add(HIST + ti[kk], 1, __ATOMIC_RELAXED, __HIP_MEMORY_SCOPE_WORKGROUP);
        }
    }
    __syncthreads();
    if (tid < 32) cnt[blockIdx.x * 32 + tid] = HIST[tid];
    __syncthreads();
    const int gw = blockIdx.x * 8 + wave, NGW = gridDim.x * 8;
    constexpr int J_GU = 16 * 64;
    for (int job = gw + a.ntail * J_GU; job < NE * J_GU; job += NGW) { const int e = job / J_GU, r = job % J_GU;
        tr_item<2>(a.in[29] + (size_t)e * 1024 * 2048, 2048, 1024, (bf16_t*)a.out + (size_t)e * 2048 * 1024, 1024, (r % 16) * 64, (r / 16) * 32, gf, lane); }
}

__device__ __forceinline__ void convert_early(const Args& a, int cw, int ncw) {
    const int tid = tidx(), wave = tid >> 6, lane = tid & 63;
    const int gw = cw * 8 + wave, NGW = ncw * 8;
    constexpr int J_GU = 16 * 64, J_DN = 16 * 32;
    const int NJ = NE * J_DN + a.ntail * J_GU;
    for (int job = gw; job < NJ; job += NGW) {
        if (job < NE * J_DN) { const int e = job / J_DN, r = job % J_DN;
            tr_item<0>(a.in[31] + (size_t)e * 1024 * 1024, 1024, 1024, (bf16_t*)(a.ws + WS_WDN) + (size_t)e * 1024 * 1024, 1024, (r % 16) * 64, (r / 16) * 32, nullptr, lane); }
        else { const int j2 = job - NE * J_DN, e = j2 / J_GU, r = j2 % J_GU;
            tr_item<2>(a.in[29] + (size_t)e * 1024 * 2048, 2048, 1024, (bf16_t*)a.out + (size_t)e * 2048 * 1024, 1024, (r % 16) * 64, (r / 16) * 32, a.in[26], lane); }
    }
}

__device__ __forceinline__ void phase_positions(const Args& a, LAS unsigned char* lds) {
    const int tid = tidx();
    LAS int* PB = (LAS int*)lds;
    LAS int* PTt = PB + 512;
    LAS int* BASE = PTt + 512;
    LAS int* TOT = BASE + 32;
    LAS int* PST = TOT + 32;
    LAS int* ENT = PST + 64;
    LAS int* RNK = ENT + 8192;
    LAS int* WC = RNK + 8192;
    const int* cnt = (const int*)(a.ws + WS_CNT); const int* tope = (const int*)(a.ws + WS_TOPE); const float* topc = (const float*)(a.ws + WS_TOPC);
    int* pos = (int*)(a.ws + WS_POS); int* tok = (int*)(a.ws + WS_TOK); float* cw = (float*)(a.ws + WS_CW); int* misc = (int*)(a.ws + WS_MISC);
    const int G = gridDim.x, RPB = (TR + G - 1) / G;
    { const int e = tid & 31, part = tid >> 5; int sb = 0, st = 0;
      for (int bb = part; bb < G; bb += 16) { const int c = cnt[bb * 32 + e]; st += c; if (bb < (int)blockIdx.x) sb += c; }
      PB[part * 32 + e] = sb; PTt[part * 32 + e] = st; }
    __syncthreads();
    if (tid < 32) { int sb = 0, st = 0;
#pragma unroll
        for (int p = 0; p < 16; ++p) { sb += PB[p * 32 + tid]; st += PTt[p * 32 + tid]; }
        BASE[tid] = sb; TOT[tid] = st; }
    __syncthreads();
    if (tid == 0) { int acc = 0; for (int e = 0; e < 32; ++e) { PST[e] = acc * 256; acc += (TOT[e] + 255) >> 8; } PST[32] = acc * 256; }
    __syncthreads();
    const int r0 = blockIdx.x * RPB, r1 = (r0 + RPB < TR) ? (r0 + RPB) : TR;
    const int nent = (r1 > r0) ? (r1 - r0) * 4 : 0;
    for (int i = tid; i < nent; i += 512) ENT[i] = tope[(size_t)r0 * 4 + i];
    __syncthreads();
    const int nchunk = (nent + 63) >> 6;
    for (int c = tid >> 6; c < nchunk; c += 8) { const int lane = tid & 63, i = c * 64 + lane; const int e = (i < nent) ? ENT[i] : -1; int myrank = 0;
        for (int q = 0; q < 32; ++q) { const unsigned long long m = __ballot(e == q); if (e == q) myrank = __popcll(m & ((1ull << lane) - 1ull)); if (lane == q) WC[c * 32 + q] = __popcll(m); }
        if (i < nent) RNK[i] = myrank; }
    __syncthreads();
    if (tid < 32) { int acc = 0; for (int c = 0; c < nchunk; ++c) { const int t = WC[c * 32 + tid]; WC[c * 32 + tid] = acc; acc += t; } }
    __syncthreads();
    for (int i = tid; i < nent; i += 512) { const int e = ENT[i], p = PST[e] + BASE[e] + WC[(i >> 6) * 32 + e] + RNK[i]; pos[(size_t)r0 * 4 + i] = p; tok[p] = r0 + (i >> 2); cw[p] = topc[(size_t)r0 * 4 + i]; }
    for (int e = blockIdx.x; e < 32; e += G) for (int p = PST[e] + TOT[e] + tid; p < PST[e + 1]; p += 512) { tok[p] = 0; cw[p] = 0.f; }
    if (blockIdx.x == 0) { const int MT = PST[32] >> 8;
        for (int m = tid; m < MT; m += 512) { int e = 0;
            for (int q = 1; q < 32; ++q) e = (PST[q] <= m * 256) ? q : e;
            misc[1 + m] = e; }
        if (tid == 0) misc[0] = MT; }
}

__device__ __forceinline__ void phase_final(const Args& a) {
    const int tid_ = tidx(), wave = tid_ >> 6, lane = tid_ & 63;
    const bf16_t* h2 = (const bf16_t*)(a.ws + WS_R5); const bf16_t* YS = (const bf16_t*)(a.ws + WS_YS); const int* pos = (const int*)(a.ws + WS_POS);
    const float* gfin = a.in[33];
    f32x4 g4[4];
#pragma unroll
    for (int j = 0; j < 4; ++j) g4[j] = ((const f32x4*)gfin)[lane + 64 * j];
    for (int row = blockIdx.x * 8 + wave; row < TR; row += gridDim.x * 8) {
        const int4 pp = *(const int4*)(pos + (size_t)row * 4);
        const int ps[4] = {pp.x, pp.y, pp.z, pp.w};
        f32x4 v[4]; float ss = 0.f;
#pragma unroll
        for (int j = 0; j < 4; ++j) { { const u32x2 hw = ((const u32x2*)(h2 + (size_t)row * D))[lane + 64 * j]; v[j] = (f32x4){bf_lo(hw.x), bf_hi(hw.x), bf_lo(hw.y), bf_hi(hw.y)}; }
#pragma unroll
            for (int k = 0; k < 4; ++k) { const u32x2 w = ((const u32x2*)(YS + (size_t)ps[k] * D))[lane + 64 * j]; v[j].x += bf_lo(w.x); v[j].y += bf_hi(w.x); v[j].z += bf_lo(w.y); v[j].w += bf_hi(w.y); }
            ss += (v[j].x * v[j].x + v[j].y * v[j].y) + (v[j].z * v[j].z + v[j].w * v[j].w); }
        const float rstd = rsqrtf(wave_sum(ss) * (1.0f / D) + EPS);
        f32x4* o = (f32x4*)(a.out + (size_t)row * D);
#pragma unroll
        for (int j = 0; j < 4; ++j) o[lane + 64 * j] = v[j] * rstd * g4[j];
    }
}

__global__ void __launch_bounds__(512, 2) fwd(Args args) {
    extern __shared__ __attribute__((aligned(16))) unsigned char smem[];
    LAS unsigned char* lds = (LAS unsigned char*)smem;
    const int lo = args.ph_lo, hi = args.ph_hi, G = gridDim.x;
    volatile LAS unsigned* MISC = (volatile LAS unsigned*)(lds + LDS_MISC);
    if (threadIdx.x < 4) MISC[threadIdx.x] = 0u;
    __syncthreads();
    XcdBarrier bar; bar.bar = (unsigned*)(args.ws + WS_BAR); bar.x = 0; bar.st = MISC;
    if (hi - lo > 1) bar = xcd_barrier_post((unsigned*)(args.ws + WS_BAR), MISC);
#define IN(k) (lo <= (k) && (k) < hi)
#define SEAM(k) do { if (IN(k) && IN((k) + 1)) xcd_barrier(bar); } while (0)
    unsigned char* ws = args.ws;
    if (IN(0)) { phase_prologue(args, lds); } SEAM(0);
    if (IN(1)) {
        pg8::ProbDense S; S.A = (const bf16_t*)(ws + WS_XB); S.lda = D; S.Bt = (const bf16_t*)(ws + WS_WIN); S.ldb = 1024; S.so.init(TR / 256, LDP / 256, G, (int)blockIdx.x, MK_WGM_INPROJ);
        pg8::EpiBf16 E{(bf16_t*)(ws + WS_P), LDP};
        pg8::gemm_phase<pg8::EpiBf16, pg8::ProbDense, 1024>(lds, S, E);
    } SEAM(1);
    if (IN(2)) { phase_lora(args, lds); } SEAM(2);
    if (IN(3)) { for (int it = blockIdx.x; it < 256; it += G) { if (it < 128) { if (!(args.flags & 2)) rwkv_item(args, lds, it); } else { if (!(args.flags & 1)) gla_item(args, lds, it - 128); } __syncthreads(); }
                 if ((int)blockIdx.x >= G / 2 && !(args.flags & 16)) convert_early(args, (int)blockIdx.x - G / 2, G - G / 2); } SEAM(3);
    if (IN(4)) { phase_glanorm(args); } SEAM(4);
    if (IN(5)) {
        pg8::ProbMix S; S.A = (const bf16_t*)(ws + WS_R5); S.Bt = (const bf16_t*)(ws + WS_WGR); S.so.init(TR / 256, 4, G, (int)blockIdx.x);
        pg8::EpiMix E{(const bf16_t*)(ws + WS_P), (bf16_t*)(ws + WS_MIX)};
        pg8::gemm_phase<pg8::EpiMix, pg8::ProbMix, 1024>(lds, S, E);
    } SEAM(5);
    if (IN(6)) {
        pg8::ProbDense S; S.A = (const bf16_t*)(ws + WS_MIX); S.lda = D; S.Bt = (const bf16_t*)(ws + WS_WOUT); S.ldb = 1024; S.so.init(TR / 256, 4, G, (int)blockIdx.x);
        pg8::EpiH2 E{args.in[0], (bf16_t*)(ws + WS_R5)};
        pg8::gemm_phase<pg8::EpiH2, pg8::ProbDense, 1024>(lds, S, E);
    } SEAM(6);
    if (IN(7)) { phase_router(args, lds); } SEAM(7);
    if (IN(8)) { phase_positions(args, lds); } SEAM(8);
    if (IN(9)) {
        const int* misc = (const int*)(ws + WS_MISC); const int MT = __builtin_amdgcn_readfirstlane(misc[0]);
        pg8::ProbMoE S; S.A = (const bf16_t*)(ws + WS_U2); S.tok = (const int*)(ws + WS_TOK); S.Bt = (const bf16_t*)args.out; S.Bt2 = S.Bt; S.ntail = 0; S.nN = 8; S.tile2e = misc + 1; S.so.init(MT, 8, G, (int)blockIdx.x, MK_WGM_MOE);
        S.rdy = nullptr; S.need = 0u; S.mask = 0u;
        pg8::EpiSwiglu E{args.in[30], (bf16_t*)(ws + WS_ACT), (unsigned*)(ws + WS_BAR) + XB_RDY};
        pg8::gemm_phase<pg8::EpiSwiglu, pg8::ProbMoE, 1024>(lds, S, E);
    }
    __syncthreads();
    if (IN(10)) {
        const int* misc = (const int*)(ws + WS_MISC); const int MT = __builtin_amdgcn_readfirstlane(misc[0]);
        const int cs = (((int)blockIdx.x - (MT * 8) % G) % G + G) % G;
        pg8::ProbMoE S; S.A = (const bf16_t*)(ws + WS_ACT); S.tok = nullptr; S.Bt = (const bf16_t*)(ws + WS_WDN); S.Bt2 = S.Bt; S.ntail = 0; S.nN = 4; S.tile2e = misc + 1; S.so.init(MT, 4, G, cs, MK_WGM_MOE);
        S.rdy = (unsigned*)(ws + WS_BAR) + XB_RDY; S.need = 64u;
        {
            const int t_ = tidx();
            if (t_ < 64) { pg8::Unit u_; unsigned ok = 1u;
                if (t_ < 32 && S.so.next(t_, u_)) ok = (xb_ld(S.rdy + u_.pm) >= S.need) ? 1u : 0u;
                const unsigned long long bal = __ballot(ok != 0u);
                __builtin_amdgcn_fence(__ATOMIC_ACQUIRE, "agent");
                asm volatile("s_waitcnt vmcnt(0)" ::: "memory");
                if (t_ == 0) MISC[16] = (unsigned)bal; }
            __syncthreads();
            S.mask = (unsigned)__builtin_amdgcn_readfirstlane((int)MISC[16]); }
        pg8::EpiDown E{args.in[32], (const float*)(ws + WS_CW), (bf16_t*)(ws + WS_YS)};
        pg8::gemm_phase<pg8::EpiDown, pg8::ProbMoE, 1024>(lds, S, E);
    } SEAM(10);
    if (IN(11)) { phase_final(args); }
#undef IN
#undef SEAM
}
}

extern "C" void kernel_launch(void* const* d_in, const int* in_sizes, int n_in, void* d_out, int out_size, void* d_ws, size_t ws_size, hipStream_t stream) {
    static int grid = 0;
    if (grid == 0) {
        if (n_in != 34 || ws_size < mk::WS_END) { fprintf(stderr, "kernel_launch: expected 34 inputs and >= %zu bytes of workspace (got %d, %zu)\n", (size_t)mk::WS_END, n_in, ws_size); grid = -1; return; }
        int dev = 0, cus = 0;
        if (hipGetDevice(&dev) != hipSuccess || hipDeviceGetAttribute(&cus, hipDeviceAttributeMultiprocessorCount, dev) != hipSuccess) { grid = -1; return; }
        if (hipFuncSetAttribute((const void*)mk::fwd, hipFuncAttributeMaxDynamicSharedMemorySize, mk::LDS_BYTES) != hipSuccess) { fprintf(stderr, "kernel_launch: hipFuncSetAttribute failed\n"); grid = -1; return; }
        int per_cu = 0;
        if (hipOccupancyMaxActiveBlocksPerMultiprocessor(&per_cu, (const void*)mk::fwd, 512, mk::LDS_BYTES) != hipSuccess || per_cu < 1) { fprintf(stderr, "kernel_launch: occupancy query says %d blocks per CU\n", per_cu); }
        (void)hipGetLastError();
        grid = cus > 0 ? cus : 256;
    }
    if (grid < 0) return;
    (void)hipMemsetAsync((char*)d_ws + mk::WS_BAR, 0, 16384, stream);
    mk::Args a{};
    for (int i = 0; i < 34; ++i) a.in[i] = (const float*)d_in[i];
    a.out = (float*)d_out; a.ws = (unsigned char*)d_ws;
    a.ntail = 32;
#if MK_SPLIT
    for (int ph = 0; ph < mk::NPHASE; ++ph) { a.ph_lo = ph; a.ph_hi = ph + 1; a.flags = 0; hipLaunchKernelGGL(mk::fwd, dim3(grid), dim3(512), mk::LDS_BYTES, stream, a);
#ifdef MK_REP
        if (ph == MK_REP) { a.flags = MK_REP_FLAGS; for (int r = 0; r < MK_REP_N; ++r) hipLaunchKernelGGL(mk::fwd, dim3(grid), dim3(512), mk::LDS_BYTES, stream, a); }
#endif
    }
#else
    a.ph_lo = 0; a.ph_hi = mk::NPHASE;
    hipLaunchKernelGGL(mk::fwd, dim3(grid), dim3(512), mk::LDS_BYTES, stream, a);
#endif
}
```

```cpp
#include <hip/hip_runtime.h>
#include <cstdio>
#include <cstdint>

#ifndef MK_WGM_INPROJ
#define MK_WGM_INPROJ 5
#endif
#ifndef MK_WGM_MOE
#define MK_WGM_MOE 4
#endif
#ifndef MK_SPLIT
#define MK_SPLIT 0
#endif

#define LAS __attribute__((address_space(3)))
typedef unsigned short bf16_t;
typedef short bf16x8 __attribute__((ext_vector_type(8)));
typedef float f32x4 __attribute__((ext_vector_type(4)));
typedef float f32x2 __attribute__((ext_vector_type(2)));
typedef unsigned u32x4 __attribute__((ext_vector_type(4)));
typedef unsigned u32x2 __attribute__((ext_vector_type(2)));

namespace mk {
constexpr int D = 1024, NBATCH = 8, SEQ = 4096, NMETA = 16, L = SEQ + NMETA, TR = NBATCH * SEQ  , MROW = TR  , PROWS = TR + NMETA;
constexpr int LDP = 8704;
constexpr int C_GQ = 0, C_GK = 512, C_GV = 1024, C_GR = 2048, C_RR = 3072, C_RK = 4096, C_RV = 5120, C_GG = 6144, C_GW = 7168,
              C_GA = 8192, C_RW = 8208, C_RA = 8272, C_RG = 8336;
constexpr int NE = 32;
constexpr float EPS = 1e-5f;
constexpr int NPHASE = 12;
__device__ __forceinline__ int prow(int b, int l) { return l < NMETA ? MROW + l : b * SEQ + (l - NMETA); }
constexpr size_t MiB = (size_t)1 << 20;
constexpr size_t WS_BAR = 0;
constexpr size_t WS_CNT = 16 * 1024;
constexpr size_t WS_MISC = 64 * 1024;
constexpr size_t WS_TOPE = 1 * MiB, WS_TOPC = 2 * MiB, WS_POS = 3 * MiB, WS_TOK = 4 * MiB, WS_CW = 5 * MiB;
constexpr size_t WS_WIN = 8 * MiB;
constexpr size_t WS_WGR = 25 * MiB;
constexpr size_t WS_WOUT = 29 * MiB;
constexpr size_t WS_WFR = 31 * MiB;
constexpr size_t WS_WRS = 31 * MiB + 704 * 1024;
constexpr size_t WS_XB = 32 * MiB;
constexpr size_t WS_P = 96 * MiB;
constexpr size_t WS_ACT = WS_P, WS_YS = WS_P + 272 * MiB;
constexpr size_t WS_LORA = 641 * MiB;
constexpr size_t LSLOT = 65 * MiB;
constexpr size_t WS_MIX = WS_LORA;
constexpr size_t WS_WGU = WS_LORA;
constexpr size_t WS_U2 = WS_LORA + 130 * MiB;
constexpr size_t WS_WDN = WS_XB;
constexpr size_t WS_R5 = 836 * MiB;
constexpr size_t WS_END = 964 * MiB;
constexpr size_t WS_TAIL = WS_END;

constexpr int LDS_BYTES = 147456;
constexpr int LDS_MISC = 147200;

struct Args { const float* in[34]; float* out; unsigned char* ws; int ph_lo, ph_hi, flags, ntail; };

__device__ __forceinline__ float bf_lo(unsigned w) { return __uint_as_float(w << 16); }
__device__ __forceinline__ float bf_hi(unsigned w) { return __uint_as_float(w & 0xffff0000u); }
__device__ __forceinline__ float bf1(bf16_t v) { return __uint_as_float(((unsigned)v) << 16); }
typedef __bf16 bf16v2 __attribute__((ext_vector_type(2)));
__device__ __forceinline__ unsigned pk2(float lo, float hi) { bf16v2 v; v.x = (__bf16)lo; v.y = (__bf16)hi; return __builtin_bit_cast(unsigned, v); }
__device__ __forceinline__ unsigned f2bf(float f) { const __bf16 b = (__bf16)f; return (unsigned)__builtin_bit_cast(unsigned short, b); }
__device__ __forceinline__ float sigmoidf_(float x) { return __builtin_amdgcn_rcpf(1.0f + __expf(-x)); }
__device__ __forceinline__ float tanhf_(float x) { return 1.0f - 2.0f * __builtin_amdgcn_rcpf(1.0f + __expf(2.0f * x)); }
__device__ __forceinline__ float wave_sum(float v) {
#pragma unroll
    for (int o = 1; o < 64; o <<= 1) v += __shfl_xor(v, o);
    return v;
}
__device__ __forceinline__ int tidx() { int t = threadIdx.x; asm volatile("" : "+v"(t)); return t; }
__device__ __forceinline__ float red16(float v) { v += __shfl_xor(v, 1); v += __shfl_xor(v, 2); v += __shfl_xor(v, 4); v += __shfl_xor(v, 8); return v; }
template <int CTRL> __device__ __forceinline__ float dppf(float v) { return __int_as_float(__builtin_amdgcn_update_dpp(0, __float_as_int(v), CTRL, 0xF, 0xF, true)); }
__device__ __forceinline__ float red8(float v) { v += dppf<0xB1>(v); v += dppf<0x4E>(v); v += dppf<0x141>(v); return v; }

#define XB_TMO      128
#define XB_XCNT(j)  (256  + 64 * (j))
#define XB_XSUB(j)  (1280 + 64 * (j))
#define XB_XGEN(j)  (2304 + 64 * (j))
#define XB_TOP      3328
#define XB_TOPGEN   3392
#define XCD_BAR_WORDS 3456
#define XB_GLA      4044
#define XB_RDY      3456
#define XB_SPIN_CAP (1u << 22)
__device__ __forceinline__ unsigned xb_ld(unsigned* p)              { return __hip_atomic_load(p, __ATOMIC_RELAXED, __HIP_MEMORY_SCOPE_AGENT); }
__device__ __forceinline__ unsigned xb_add(unsigned* p, unsigned v) { return __hip_atomic_fetch_add(p, v, __ATOMIC_RELAXED, __HIP_MEMORY_SCOPE_AGENT); }
__device__ __forceinline__ unsigned xb_xcc_id() { return (unsigned)__builtin_amdgcn_s_getreg((3 << 11) | 20) & 0xFu; }
#define XB_SPIN(cond, bar) do { unsigned _sp = 0; while (cond) { __builtin_amdgcn_s_sleep(1); \
    if ((++_sp & 255u) == 0u) { if (xb_ld(&(bar)[XB_TMO])) break; if (_sp > XB_SPIN_CAP) { atomicAdd(&(bar)[XB_TMO], 1u); break; } } } } while (0)
struct XcdBarrier { unsigned* bar; unsigned x; volatile LAS unsigned* st; };
__device__ __forceinline__ XcdBarrier xcd_barrier_post(unsigned* bar, volatile LAS unsigned* st) {
    XcdBarrier b; b.bar = bar; b.x = xb_xcc_id(); b.st = st;
    if (threadIdx.x == 0) (void)xb_add(&bar[XB_XCNT(b.x)], 1u);
    return b;
}
__device__ __forceinline__ void xcd_barrier_complete(unsigned* bar, unsigned x, unsigned& nloc, unsigned& nx) {
    const unsigned G = gridDim.x * gridDim.y * gridDim.z;
    unsigned sum, cnt, mine, sp = 0u;
    for (;;) {
        sum = 0u; cnt = 0u; mine = 0u;
#pragma unroll
        for (unsigned j = 0; j < 16; ++j) { const unsigned c = xb_ld(&bar[XB_XCNT(j)]); sum += c; cnt += (c > 0u) ? 1u : 0u; mine = (j == x) ? c : mine; }
        if (sum == G) break;
        __builtin_amdgcn_s_sleep(1);
        if ((++sp & 255u) == 0u) { if (xb_ld(&bar[XB_TMO])) break; if (sp > XB_SPIN_CAP) { atomicAdd(&bar[XB_TMO], 1u); break; } }
    }
    nloc = mine > 0u ? mine : 1u; nx = cnt > 0u ? cnt : 1u;
}
__device__ __forceinline__ void xcd_barrier(const XcdBarrier& b) {
    asm volatile("s_waitcnt vmcnt(0)" ::: "memory");
    __syncthreads();
    if (threadIdx.x == 0) {
        unsigned* bar = b.bar;
        __builtin_amdgcn_s_waitcnt(0);
        unsigned nloc = b.st[0], nx = b.st[1];
        if (nloc == 0u) { xcd_barrier_complete(bar, b.x, nloc, nx); b.st[0] = nloc; b.st[1] = nx; }
        const unsigned old = xb_add(&bar[XB_XSUB(b.x)], 1u);
        const unsigned gen = old / nloc;
        if (old + 1u == (gen + 1u) * nloc) {
            __builtin_amdgcn_fence(__ATOMIC_RELEASE, "agent");
            asm volatile("s_waitcnt vmcnt(0)" ::: "memory");
            const unsigned og = xb_add(&bar[XB_TOP], 1u);
            const unsigned tg = og / nx;
            if (og + 1u == (tg + 1u) * nx) xb_add(&bar[XB_TOPGEN], 1u);
            else XB_SPIN(xb_ld(&bar[XB_TOPGEN]) == tg, bar);
            __builtin_amdgcn_fence(__ATOMIC_ACQUIRE, "agent");
            xb_add(&bar[XB_XGEN(b.x)], 1u);
            asm volatile("s_waitcnt vmcnt(0)" ::: "memory");
        } else {
            XB_SPIN(xb_ld(&bar[XB_XGEN(b.x)]) == gen, bar);
            __builtin_amdgcn_fence(__ATOMIC_ACQUIRE, "agent");
            asm volatile("s_waitcnt vmcnt(0)" ::: "memory");
        }
    }
    __syncthreads();
}

#ifndef MK_ST_AUX
#define MK_ST_AUX 2
#endif
namespace pg8 {
constexpr int BM = 256, BK = 64, HALF = 128, HTB = HALF * BK * 2, STAGE_BYTES = 8 * HTB, NXCD = 8, WGM = 8;
__host__ __device__ __forceinline__ int lds_byte(int r, int c) { const int st = (r >> 4) * 2 + (c >> 5), rr = r & 15, cc = c & 31, ob = rr * 64 + cc * 2; return st * 1024 + (ob ^ (((ob >> 9) & 1) << 5)); }
__host__ __device__ __forceinline__ void stage_rc(int b, int& R, int& C) { const int st = b / 1024, sb = b % 1024, swz = sb ^ (((sb >> 9) & 1) << 5); R = (st >> 1) * 16 + swz / 64; C = (st & 1) * 32 + (swz % 64) / 2; }
__host__ __device__ __forceinline__ int perm32(int rho) { const int n = rho >> 4, i = rho & 15; return 8 * (i >> 2) + 4 * n + (i & 3); }
struct Unit { int pm, pn, e; };
struct StaticOrder {
    int nM, nN, nwg, G, c, wgm;
    __device__ __forceinline__ void init(int nM_, int nN_, int G_, int c_, int wgm_ = WGM) { nM = nM_; nN = nN_; nwg = nM * nN; G = G_; c = c_; wgm = wgm_; }
    __device__ __forceinline__ bool next(int i, Unit& u) const {
        const long Lx = (long)i * G + c; if (Lx >= nwg) return false;
        int wgid = (int)Lx; { const int q = nwg / NXCD, r = nwg % NXCD, xcd = wgid % NXCD, off = wgid / NXCD; wgid = (xcd < r ? xcd * (q + 1) : r * (q + 1) + (xcd - r) * q) + off; }
        const int nig = wgm * nN, gid = wgid / nig, fm = gid * wgm, gsz = (nM - fm) < wgm ? (nM - fm) : wgm;
        u.pm = fm + ((wgid % nig) % gsz); u.pn = (wgid % nig) / gsz; return true;
    }
};
__device__ __forceinline__ unsigned cvt_pk_bf16(float lo, float hi) { return pk2(lo, hi); }

struct ProbDense {
    const bf16_t* A; int lda; const bf16_t* Bt; int ldb; StaticOrder so;
    __device__ __forceinline__ bool next(int i, Unit& u) const { u.e = 0; return so.next(i, u); }
    __device__ __forceinline__ const char* a_base(const Unit& u) const { return (const char*)(A + (size_t)u.pm * 256 * lda); }
    __device__ __forceinline__ const char* b_base(const Unit& u) const { return (const char*)(Bt + (size_t)u.pn * 256 * ldb); }
    __device__ __forceinline__ void a_ready(int, const Unit&, int) const {}
    __device__ __forceinline__ void a_off(const Unit&, const int (&R)[2], const int (&C)[2], unsigned (&v)[2][2]) const {
#pragma unroll
        for (int h = 0; h < 2; ++h)
#pragma unroll
            for (int i = 0; i < 2; ++i) v[h][i] = (unsigned)(((h * HALF + R[i]) * lda + C[i]) * 2);
    }
};
struct ProbMix {
    const bf16_t* A; const bf16_t* Bt; StaticOrder so;
    __device__ __forceinline__ bool next(int i, Unit& u) const { if (!so.next(i >> 1, u)) return false; u.e = i & 1; return true; }
    __device__ __forceinline__ const char* a_base(const Unit& u) const { return (const char*)(A + (size_t)u.pm * 256 * 2048 + u.e * 1024); }
    __device__ __forceinline__ const char* b_base(const Unit& u) const { return (const char*)(Bt + (size_t)u.e * 1024 * 1024 + (size_t)u.pn * 256 * 1024); }
    __device__ __forceinline__ void a_ready(int, const Unit&, int) const {}
    __device__ __forceinline__ void a_off(const Unit&, const int (&R)[2], const int (&C)[2], unsigned (&v)[2][2]) const {
#pragma unroll
        for (int h = 0; h < 2; ++h)
#pragma unroll
            for (int i = 0; i < 2; ++i) v[h][i] = (unsigned)(((h * HALF + R[i]) * 2048 + C[i]) * 2);
    }
};
struct ProbMoE {
    const bf16_t* A; const int* tok; const bf16_t* Bt; const bf16_t* Bt2; int ntail; int nN; const int* tile2e; StaticOrder so;
    unsigned* rdy; unsigned need, mask;
    __device__ __forceinline__ void a_ready(int i, const Unit& u, int wid) const {
        if (rdy == nullptr || (i < 32 && ((mask >> i) & 1u))) return;
        if (wid == 0) { unsigned sp = 0u;
            while ((unsigned)__builtin_amdgcn_readfirstlane(xb_ld(rdy + u.pm)) < need) { __builtin_amdgcn_s_sleep(2); if (++sp > XB_SPIN_CAP) break; }
            __builtin_amdgcn_fence(__ATOMIC_ACQUIRE, "agent");
            asm volatile("s_waitcnt vmcnt(0)" ::: "memory"); }
        asm volatile("" ::: "memory"); __builtin_amdgcn_s_barrier(); asm volatile("" ::: "memory");
    }
    __device__ __forceinline__ bool next(int i, Unit& u) const { if (!so.next(i, u)) return false; u.e = __builtin_amdgcn_readfirstlane(tile2e[u.pm]); return true; }
    __device__ __forceinline__ const char* a_base(const Unit& u) const { return tok ? (const char*)A : (const char*)(A + (size_t)u.pm * 256 * 1024); }
    __device__ __forceinline__ const char* b_base(const Unit& u) const { return (u.e < ntail) ? (const char*)(Bt2 + ((size_t)u.e * nN + u.pn) * 256 * 1024) : (const char*)(Bt + ((size_t)(u.e - ntail) * nN + u.pn) * 256 * 1024); }
    __device__ __forceinline__ void a_off(const Unit& u, const int (&R)[2], const int (&C)[2], unsigned (&v)[2][2]) const {
#pragma unroll
        for (int h = 0; h < 2; ++h)
#pragma unroll
            for (int i = 0; i < 2; ++i) { const int row = tok ? tok[u.pm * 256 + h * HALF + R[i]] : (h * HALF + R[i]); v[h][i] = (unsigned)((row * 1024 + C[i]) * 2); }
    }
};

typedef f32x4 Acc[2][2][4][2];

template <class Epi, class Prob, int K>
__device__ __forceinline__ void gemm_phase(LAS unsigned char* lds, const Prob& S, const Epi& E) {
    const int tid = tidx(), wid = __builtin_amdgcn_readfirstlane(tid >> 6), lane = tid & 63, wr = wid >> 2, wc = wid & 3, fr = lane & 15, fq = lane >> 4;
    constexpr int nt = K / BK;
    int R[2], C[2]; unsigned voffB[2], voffB1[2];
#pragma unroll
    for (int i = 0; i < 2; ++i) { stage_rc(tid * 16 + i * 8192, R[i], C[i]);
        if constexpr (Epi::PERM64) {
            const int Rq = 64 * (R[i] >> 5) + 16 * ((R[i] & 15) >> 2) + 4 * ((R[i] >> 4) & 1) + (R[i] & 3);
            voffB[i] = (unsigned)(Rq * K + C[i]) * 2u; voffB1[i] = (unsigned)((Rq + 8) * K + C[i]) * 2u; }
        else { const int Rb = Epi::PERM ? ((R[i] & ~31) + perm32(R[i] & 31)) : R[i]; voffB[i] = (unsigned)(Rb * K + C[i]) * 2u; voffB1[i] = voffB[i]; } }
    const size_t kstep = (size_t)(BK * 2);
    const size_t hstep = Epi::PERM64 ? 0 : (size_t)HALF * K * 2;

    const unsigned ldsw = (unsigned)wid * 1024u;
    const int aoff = lds_byte(wr * 64 + fr, fq * 8), boff = lds_byte(wc * 32 + fr, fq * 8);
#define PG8_SA(b, h) (((b) * 2 + (h)) * HTB)
#define PG8_SB(b, h) ((4 + (b) * 2 + (h)) * HTB)
#define PG8_STAGE(bufoff, gbase, voff) do { _Pragma("unroll") for (int _i = 0; _i < 2; ++_i) \
        __builtin_amdgcn_global_load_lds((const unsigned*)((const char*)(gbase) + (voff)[_i]), (LAS unsigned*)(lds + (bufoff) + ldsw + _i * 8192), 16, 0, 0); } while (0)
#define PG8_LDA(dst, b, h) do { _Pragma("unroll") for (int m = 0; m < 4; ++m) _Pragma("unroll") for (int k = 0; k < 2; ++k) dst[m][k] = *(const LAS bf16x8*)(lds + PG8_SA(b, h) + aoff + m * 2048 + k * 1024); } while (0)
#define PG8_LDB(dst, b, h) do { _Pragma("unroll") for (int n = 0; n < 2; ++n) _Pragma("unroll") for (int k = 0; k < 2; ++k) dst[n][k] = *(const LAS bf16x8*)(lds + PG8_SB(b, h) + boff + n * 2048 + k * 1024); } while (0)
#define PG8_MMA(ai, bj, At, Bt) do { __builtin_amdgcn_s_setprio(1); _Pragma("unroll") for (int m = 0; m < 4; ++m) _Pragma("unroll") for (int n = 0; n < 2; ++n) _Pragma("unroll") for (int k = 0; k < 2; ++k) \
        acc[ai][bj][m][n] = __builtin_amdgcn_mfma_f32_16x16x32_bf16(Bt[n][k], At[m][k], acc[ai][bj][m][n], 0, 0, 0); __builtin_amdgcn_s_setprio(0); } while (0)
#define PG8_WAIT_V(n) asm volatile("s_waitcnt vmcnt(" #n ")" ::: "memory")
#define PG8_WAIT_L(n) asm volatile("s_waitcnt lgkmcnt(" #n ")" ::: "memory")
#define PG8_BAR __builtin_amdgcn_s_barrier()
#define PG8_SCHED __builtin_amdgcn_sched_barrier(0)
    Unit cur, nxt; int ui = 0;
    if (!S.next(0, cur)) return;
    Acc acc;
#pragma unroll
    for (int a = 0; a < 2; ++a)
#pragma unroll
        for (int b = 0; b < 2; ++b)
#pragma unroll
            for (int m = 0; m < 4; ++m)
#pragma unroll
                for (int n = 0; n < 2; ++n) acc[a][b][m][n] = (f32x4){0.f, 0.f, 0.f, 0.f};
    bf16x8 At[4][2], B0[2][2], B1[2][2];
    unsigned va[2][2], vn[2][2];
    S.a_off(cur, R, C, va);
    const char* cA = S.a_base(cur); const char* cB = S.b_base(cur);
    int pend = -1;
    S.a_ready(0, cur, wid);
    PG8_STAGE(PG8_SB(0, 0), cB, voffB); PG8_STAGE(PG8_SB(0, 1), cB + hstep, voffB1); PG8_STAGE(PG8_SA(0, 0), cA, va[0]); PG8_STAGE(PG8_SA(0, 1), cA, va[1]);
    if (wr == 1) PG8_BAR;
    PG8_WAIT_V(2); PG8_BAR;
    PG8_STAGE(PG8_SB(1, 0), cB + kstep, voffB); PG8_STAGE(PG8_SA(1, 0), cA + kstep, va[0]); PG8_STAGE(PG8_SB(1, 1), cB + hstep + kstep, voffB1);
    PG8_WAIT_V(6); PG8_BAR;
    for (;;) {
        const bool has_next = S.next(ui + 1, nxt);
        const char* nA = cA; const char* nB = cB;
#pragma unroll
        for (int h = 0; h < 2; ++h)
#pragma unroll
            for (int i = 0; i < 2; ++i) vn[h][i] = va[h][i];
        if (has_next) { nA = S.a_base(nxt); nB = S.b_base(nxt); S.a_off(nxt, R, C, vn); }
        for (int t = 0; t < nt; t += 2) {
            const bool last = (t == nt - 2);
            const char* a1 = cA + (size_t)(t + 1) * kstep;
            const char* a2 = last ? nA : cA + (size_t)(t + 2) * kstep; const char* b2 = last ? nB : cB + (size_t)(t + 2) * kstep;
            const char* a3 = a2 + kstep; const char* b3 = b2 + kstep;
            unsigned v2[2][2];
#pragma unroll
            for (int h = 0; h < 2; ++h)
#pragma unroll
                for (int i = 0; i < 2; ++i) v2[h][i] = last ? vn[h][i] : va[h][i];
            if constexpr (Epi::PUB) { if (t == 4 && pend >= 0) { E.publish(pend, lane); pend = -1; } }
            if (last && has_next) S.a_ready(ui + 1, nxt, wid);
            PG8_LDB(B0, 0, 0); PG8_LDB(B1, 0, 1); PG8_SCHED; PG8_LDA(At, 0, 0); PG8_STAGE(PG8_SA(1, 1), a1, va[1]);
            PG8_WAIT_V(8); PG8_WAIT_L(0); PG8_BAR; PG8_MMA(0, 0, At, B0); PG8_MMA(0, 1, At, B1); PG8_BAR; PG8_SCHED;
            PG8_LDA(At, 0, 1); PG8_STAGE(PG8_SB(0, 0), b2, voffB); PG8_STAGE(PG8_SB(0, 1), b2 + hstep, voffB1); PG8_STAGE(PG8_SA(0, 0), a2, v2[0]);
            PG8_WAIT_V(8); PG8_WAIT_L(0); PG8_BAR; PG8_MMA(1, 0, At, B0); PG8_MMA(1, 1, At, B1); PG8_BAR; PG8_SCHED;
            PG8_LDB(B0, 1, 0); PG8_LDB(B1, 1, 1); PG8_SCHED; PG8_LDA(At, 1, 0); PG8_STAGE(PG8_SA(0, 1), a2, v2[1]);
            PG8_WAIT_V(8); PG8_WAIT_L(0); PG8_BAR; PG8_MMA(0, 0, At, B0); PG8_MMA(0, 1, At, B1); PG8_BAR; PG8_SCHED;
            PG8_LDA(At, 1, 1); PG8_STAGE(PG8_SB(1, 0), b3, voffB); PG8_STAGE(PG8_SB(1, 1), b3 + hstep, voffB1); PG8_STAGE(PG8_SA(1, 0), a3, v2[0]);
            PG8_WAIT_V(8); PG8_WAIT_L(0); PG8_BAR; PG8_MMA(1, 0, At, B0); PG8_MMA(1, 1, At, B1); PG8_BAR; PG8_SCHED;
        }
        if (wr == 0) PG8_BAR;
        E(acc, cur, wr, wc, fr, fq);
        if constexpr (Epi::PUB) pend = __builtin_amdgcn_readfirstlane(cur.pm);
        if (!has_next) break;
        if (!(Epi::KEEP && cur.e == 0)) {
#pragma unroll
        for (int a = 0; a < 2; ++a)
#pragma unroll
            for (int b = 0; b < 2; ++b)
#pragma unroll
                for (int m = 0; m < 4; ++m)
#pragma unroll
                    for (int n = 0; n < 2; ++n) acc[a][b][m][n] = (f32x4){0.f, 0.f, 0.f, 0.f};
        }
        cur = nxt; cA = nA; cB = nB; ++ui;
#pragma unroll
        for (int h = 0; h < 2; ++h)
#pragma unroll
            for (int i = 0; i < 2; ++i) va[h][i] = vn[h][i];
        if (wr == 1) PG8_BAR;
    }
    PG8_WAIT_V(0);
    if constexpr (Epi::PUB) { if (pend >= 0) E.publish(pend, lane); }
    PG8_BAR;
#undef PG8_SA
#undef PG8_SB
#undef PG8_STAGE
#undef PG8_LDA
#undef PG8_LDB
#undef PG8_MMA
#undef PG8_WAIT_V
#undef PG8_WAIT_L
#undef PG8_BAR
#undef PG8_SCHED
}

constexpr float GATE_SCALE = 16.0f;
__device__ __forceinline__ void gate8(const bf16_t* Prow, int gcol, float (&g)[8]) {
    const u32x2 w = *(const u32x2*)((const unsigned char*)(Prow + C_GG) + gcol);
#pragma unroll
    for (int q = 0; q < 2; ++q) { const f32x2 lo = __builtin_amdgcn_cvt_pk_f32_fp8((int)w[q], false), hi = __builtin_amdgcn_cvt_pk_f32_fp8((int)w[q], true);
        g[4 * q] = lo.x * (1.0f / GATE_SCALE); g[4 * q + 1] = lo.y * (1.0f / GATE_SCALE); g[4 * q + 2] = hi.x * (1.0f / GATE_SCALE); g[4 * q + 3] = hi.y * (1.0f / GATE_SCALE); }
}
struct EpiBf16 {
    static constexpr bool PERM = true, KEEP = false, PUB = false, PERM64 = false; static constexpr int NST = 16;
    bf16_t* O; int ldc;
    __device__ __forceinline__ void operator()(Acc& acc, const Unit& u, int wr, int wc, int fr, int fq) const {
        const int row0 = u.pm * BM + wr * 64 + fr, col0 = u.pn * BM + wc * 32 + 8 * fq;
        const __amdgpu_buffer_rsrc_t rs = __builtin_amdgcn_make_buffer_rsrc((void*)O, (short)0, 0x7ffffff0, 0x00020000);
        const bool gate = (u.pn >= C_GG / BM) && (u.pn < C_GA / BM);
#pragma unroll
        for (int ai = 0; ai < 2; ++ai)
#pragma unroll
            for (int m = 0; m < 4; ++m) { const unsigned rb = (unsigned)((row0 + ai * HALF + m * 16) * ldc) * 2u;
#pragma unroll
                for (int bj = 0; bj < 2; ++bj) { const f32x4 v0 = acc[ai][bj][m][0], v1 = acc[ai][bj][m][1];
                    if (!gate) { u32x4 w; w.x = cvt_pk_bf16(v0[0], v0[1]); w.y = cvt_pk_bf16(v0[2], v0[3]); w.z = cvt_pk_bf16(v1[0], v1[1]); w.w = cvt_pk_bf16(v1[2], v1[3]);
                        __builtin_amdgcn_raw_buffer_store_b128(w, rs, (int)(rb + (unsigned)(col0 + bj * HALF) * 2u), 0, MK_ST_AUX); }
                    else { float o[8];
#pragma unroll
                        for (int j = 0; j < 4; ++j) { o[j] = __builtin_amdgcn_fmed3f(v0[j] * GATE_SCALE, -440.0f, 440.0f); o[4 + j] = __builtin_amdgcn_fmed3f(v1[j] * GATE_SCALE, -440.0f, 440.0f); }
                        int p0 = __builtin_amdgcn_cvt_pk_fp8_f32(o[0], o[1], 0, false); p0 = __builtin_amdgcn_cvt_pk_fp8_f32(o[2], o[3], p0, true);
                        int p1 = __builtin_amdgcn_cvt_pk_fp8_f32(o[4], o[5], 0, false); p1 = __builtin_amdgcn_cvt_pk_fp8_f32(o[6], o[7], p1, true);
                        __builtin_amdgcn_raw_buffer_store_b64((u32x2){(unsigned)p0, (unsigned)p1}, rs, (int)(rb + (unsigned)C_GG * 2u + (unsigned)(col0 + bj * HALF - C_GG)), 0, MK_ST_AUX); } } }
    }
};
struct EpiMix {
    static constexpr bool PERM = true, KEEP = true, PUB = false, PERM64 = false; static constexpr int NST = 16;
    const bf16_t* P; bf16_t* O;
    __device__ __forceinline__ void operator()(Acc& acc, const Unit& u, int wr, int wc, int fr, int fq) const { if (u.e == 0) first(acc, u, wr, wc, fr, fq); else second(acc, u, wr, wc, fr, fq); }
    __device__ __forceinline__ void first(Acc& acc, const Unit& u, int wr, int wc, int fr, int fq) const {
        const int row0 = u.pm * BM + wr * 64 + fr, col0 = u.pn * BM + wc * 32 + 8 * fq;
#pragma unroll
        for (int ai = 0; ai < 2; ++ai)
#pragma unroll
            for (int m = 0; m < 4; ++m) { const bf16_t* rowq = P + (size_t)(row0 + ai * HALF + m * 16) * LDP;
#pragma unroll
                for (int bj = 0; bj < 2; ++bj) {
                    float a[8], b[8];
                    gate8(rowq, col0 + bj * HALF, a); gate8(rowq, 1024 + col0 + bj * HALF, b);
#pragma unroll
                    for (int j = 0; j < 8; ++j) { const float ratio = (1.0f + __expf(-b[j])) * __builtin_amdgcn_rcpf(1.0f + __expf(-a[j])); acc[ai][bj][m][j >> 2][j & 3] *= ratio; }
                } }
    }
    __device__ __forceinline__ void second(Acc& acc, const Unit& u, int wr, int wc, int fr, int fq) const {
        const int row0 = u.pm * BM + wr * 64 + fr, col0 = u.pn * BM + wc * 32 + 8 * fq;
#pragma unroll
        for (int ai = 0; ai < 2; ++ai)
#pragma unroll
            for (int m = 0; m < 4; ++m) { const size_t r = (size_t)(row0 + ai * HALF + m * 16);
#pragma unroll
                for (int bj = 0; bj < 2; ++bj) {
                    float b[8];
                    gate8(P + r * LDP, 1024 + col0 + bj * HALF, b);
                    float o[8];
#pragma unroll
                    for (int j = 0; j < 8; ++j) o[j] = acc[ai][bj][m][j >> 2][j & 3] * sigmoidf_(b[j]);
                    u32x4 w; w.x = cvt_pk_bf16(o[0], o[1]); w.y = cvt_pk_bf16(o[2], o[3]); w.z = cvt_pk_bf16(o[4], o[5]); w.w = cvt_pk_bf16(o[6], o[7]);
                    *(u32x4*)(O + r * D + col0 + bj * HALF) = w; } }
    }
};
struct EpiH2 {
    static constexpr bool PERM = true, KEEP = false, PUB = false, PERM64 = false; static constexpr int NST = 16;
    const float* x; bf16_t* O;
    __device__ __forceinline__ void operator()(Acc& acc, const Unit& u, int wr, int wc, int fr, int fq) const {
        const int row0 = u.pm * BM + wr * 64 + fr, col0 = u.pn * BM + wc * 32 + 8 * fq;
        u32x4 pk[2][4][2];
#pragma unroll
        for (int ai = 0; ai < 2; ++ai)
#pragma unroll
            for (int m = 0; m < 4; ++m)
#pragma unroll
                for (int bj = 0; bj < 2; ++bj) { const f32x4 v0 = acc[ai][bj][m][0], v1 = acc[ai][bj][m][1];
                    pk[ai][m][bj] = (u32x4){cvt_pk_bf16(v0[0], v0[1]), cvt_pk_bf16(v0[2], v0[3]), cvt_pk_bf16(v1[0], v1[1]), cvt_pk_bf16(v1[2], v1[3])}; }
#pragma unroll
        for (int ai = 0; ai < 2; ++ai) {
            f32x4 xv[4][2][2];
#pragma unroll
            for (int m = 0; m < 4; ++m)
#pragma unroll
                for (int bj = 0; bj < 2; ++bj) { const float* src = x + (size_t)(row0 + ai * HALF + m * 16) * D + col0 + bj * HALF; xv[m][bj][0] = *(const f32x4*)src; xv[m][bj][1] = *(const f32x4*)(src + 4); }
#pragma unroll
            for (int m = 0; m < 4; ++m)
#pragma unroll
                for (int bj = 0; bj < 2; ++bj) { const u32x4 q = pk[ai][m][bj]; const f32x4 a0 = xv[m][bj][0], a1 = xv[m][bj][1];
                    u32x4 w; w.x = cvt_pk_bf16(a0[0] + bf_lo(q.x), a0[1] + bf_hi(q.x)); w.y = cvt_pk_bf16(a0[2] + bf_lo(q.y), a0[3] + bf_hi(q.y));
                    w.z = cvt_pk_bf16(a1[0] + bf_lo(q.z), a1[1] + bf_hi(q.z)); w.w = cvt_pk_bf16(a1[2] + bf_lo(q.w), a1[3] + bf_hi(q.w));
                    *(u32x4*)(O + (size_t)(row0 + ai * HALF + m * 16) * D + col0 + bj * HALF) = w; }
        }
    }
};
struct EpiSwiglu {
    static constexpr bool PERM = true, KEEP = false, PUB = true, PERM64 = false; static constexpr int NST = 8;
    const float* bgu; bf16_t* O; unsigned* rdy;
    __device__ __forceinline__ void publish(int pm, int lane) const { if (lane == 0) __hip_atomic_fetch_add(rdy + pm, 1u, __ATOMIC_RELAXED, __HIP_MEMORY_SCOPE_AGENT); }
    __device__ __forceinline__ void operator()(Acc& acc, const Unit& u, int wr, int wc, int fr, int fq) const {
        const int row0 = u.pm * BM + wr * 64 + fr, d0 = u.pn * HALF + wc * 32 + 8 * fq;
        const float* bg = bgu + (size_t)u.e * 2048 + d0;
        const __amdgpu_buffer_rsrc_t rs = __builtin_amdgcn_make_buffer_rsrc((void*)O, (short)0, 0x7ffffff0, 0x00020000);
        float bgate[8], bup[8];
        { const f32x4 t0 = *(const f32x4*)bg, t1 = *(const f32x4*)(bg + 4), t2 = *(const f32x4*)(bg + 1024), t3 = *(const f32x4*)(bg + 1028);
#pragma unroll
          for (int j = 0; j < 4; ++j) { bgate[j] = t0[j]; bgate[4 + j] = t1[j]; bup[j] = t2[j]; bup[4 + j] = t3[j]; } }
#pragma unroll
        for (int ai = 0; ai < 2; ++ai)
#pragma unroll
            for (int m = 0; m < 4; ++m) { const size_t r = (size_t)(row0 + ai * HALF + m * 16);
                float o[8];
#pragma unroll
                for (int j = 0; j < 8; ++j) {
                    float g = acc[ai][0][m][j >> 2][j & 3] + bgate[j], up = acc[ai][1][m][j >> 2][j & 3] + bup[j];
                    g = fminf(g, 7.0f); up = fminf(fmaxf(up, -7.0f), 7.0f);
                    o[j] = (up + 1.0f) * (g * sigmoidf_(1.702f * g)); }
                u32x4 w; w.x = cvt_pk_bf16(o[0], o[1]); w.y = cvt_pk_bf16(o[2], o[3]); w.z = cvt_pk_bf16(o[4], o[5]); w.w = cvt_pk_bf16(o[6], o[7]);
                __builtin_amdgcn_raw_buffer_store_b128(w, rs, (int)(((unsigned)r * D + d0) * 2u), 0, 16); }
    }
};
constexpr float YS_SCALE = 64.0f;
struct EpiDown {
    static constexpr bool PERM = true, KEEP = false, PUB = false, PERM64 = true; static constexpr int NST = 8;
    const float* bdn; const float* cw; unsigned char* O;
    __device__ __forceinline__ void operator()(Acc& acc, const Unit& u, int wr, int wc, int fr, int fq) const {
        const int row0 = u.pm * BM + wr * 64 + fr, col0 = u.pn * BM + wc * 64 + 16 * fq;
        const float* bb = bdn + (size_t)u.e * D + col0;
        float bias[16];
#pragma unroll
        for (int q = 0; q < 4; ++q) { const f32x4 t = *(const f32x4*)(bb + 4 * q);
#pragma unroll
            for (int j = 0; j < 4; ++j) bias[4 * q + j] = t[j]; }
#pragma unroll
        for (int ai = 0; ai < 2; ++ai)
#pragma unroll
            for (int m = 0; m < 4; ++m) { const size_t r = (size_t)(row0 + ai * HALF + m * 16); const float c = cw[r] * YS_SCALE;
                u32x4 w;
#pragma unroll
                for (int bj = 0; bj < 2; ++bj)
#pragma unroll
                    for (int n = 0; n < 2; ++n) { float o[4];
#pragma unroll
                        for (int j = 0; j < 4; ++j) o[j] = __builtin_amdgcn_fmed3f((acc[ai][bj][m][n][j] + bias[8 * bj + 4 * n + j]) * c, -440.0f, 440.0f);
                        int pk = __builtin_amdgcn_cvt_pk_fp8_f32(o[0], o[1], 0, false); pk = __builtin_amdgcn_cvt_pk_fp8_f32(o[2], o[3], pk, true);
                        w[2 * bj + n] = (unsigned)pk; }
                *(u32x4*)(O + r * D + col0) = w; }
    }
};
}

__device__ __forceinline__ int win_srccol(int n) {
    if (n < 3072) return n;
    if (n < 6144) return 3088 + (n - 3072);
    if (n < 8192) return 6448 + (n - 6144);
    if (n < 8208) return 3072 + (n - 8192);
    if (n < 8496) return 6160 + (n - 8208);
    return -1;
}
template <int MODE, bool NT = false>
__device__ __forceinline__ void tr_item(const float* src, int ld, int kvalid, bf16_t* dst, int dld, int k0, int n0, const float* scale, int lane) {
    const int kr = lane >> 3, c4 = (lane & 7) * 4, n = n0 + c4, kb = k0 + 8 * kr;
    int sc;
    if (MODE == 0) sc = n; else if (MODE == 1) sc = win_srccol(n); else { const int pn = n >> 8, r = n & 255, d = pn * 128 + (r & 127); sc = (r < 128) ? d : 1024 + d; }
    f32x4 v[8];
#pragma unroll
    for (int i = 0; i < 8; ++i) { v[i] = (f32x4){0.f, 0.f, 0.f, 0.f}; if (sc >= 0 && kb + i < kvalid) v[i] = *(const f32x4*)(src + (size_t)(kb + i) * ld + sc); }
    if (scale) { const f32x4 s0 = *(const f32x4*)(scale + kb), s1 = *(const f32x4*)(scale + kb + 4);
#pragma unroll
        for (int i = 0; i < 4; ++i) { v[i] = v[i] * s0[i]; v[4 + i] = v[4 + i] * s1[i]; } }
#pragma unroll
    for (int j = 0; j < 4; ++j) {
        u32x4 o; o.x = pk2(v[0][j], v[1][j]); o.y = pk2(v[2][j], v[3][j]); o.z = pk2(v[4][j], v[5][j]); o.w = pk2(v[6][j], v[7][j]);
        if (NT) __builtin_nontemporal_store(o, (u32x4*)(dst + (size_t)(n + j) * dld + kb)); else *(u32x4*)(dst + (size_t)(n + j) * dld + kb) = o; }
}

__device__ __forceinline__ void phase_prologue(const Args& a, LAS unsigned char* lds) {
    unsigned char* ws = a.ws;
    const int tid = tidx(), wave = tid >> 6, lane = tid & 63;
    { const float* wrt = a.in[27]; const float* gfn = a.in[26]; bf16_t* wrs = (bf16_t*)(ws + WS_WRS);
      for (int i = blockIdx.x * 512 + tid; i < 1024 * 32; i += gridDim.x * 512) { const int k = i >> 5, e = i & 31; const float w = wrt[i] * gfn[k]; const unsigned hi = f2bf(w);
          wrs[e * 1024 + k] = (bf16_t)hi; wrs[32768 + e * 1024 + k] = (bf16_t)f2bf(w - bf1((bf16_t)hi)); } }
    {
        bf16_t* wfr = (bf16_t*)(ws + WS_WFR);
#define WFR_FILL(SRC, KV, SLOT0, NKS) for (int i = blockIdx.x * 512 + tid; i < 64 * (NKS) * 64; i += gridDim.x * 512) { const int ln = i & 63, ks = (i >> 6) % (NKS), pu = (i >> 6) / (NKS), fr_ = ln & 15, fq_ = ln >> 4; \
            const int n = 32 * (pu >> 1) + 8 * (fr_ >> 2) + 4 * (pu & 1) + (fr_ & 3), k0 = 32 * ks + 8 * fq_; const float* sp = (SRC) + (size_t)k0 * 1024 + n; \
            u32x4 w = (u32x4){0u, 0u, 0u, 0u}; \
            if (k0 < (KV)) { w.x = pk2(sp[0], sp[1024]); w.y = pk2(sp[2048], sp[3072]); w.z = pk2(sp[4096], sp[5120]); w.w = pk2(sp[6144], sp[7168]); } \
            *(u32x4*)(wfr + ((size_t)(pu * 10 + (SLOT0) + ks) * 64 + ln) * 8) = w; }
        WFR_FILL(a.in[14], 64, 0, 2)
        WFR_FILL(a.in[16], 64, 2, 2)
        WFR_FILL(a.in[18], 160, 4, 6)
#undef WFR_FILL
    }
    const int gw = blockIdx.x * 8 + wave, NGW = gridDim.x * 8;
    constexpr int J_WIN = 16 * 272, J_SQ = 16 * 32;
    constexpr int NJ = J_WIN + 3 * J_SQ;
    for (int job = gw; job < NJ; job += NGW) {
        int r = job;
        if (r < J_WIN) { tr_item<1>(a.in[3], 8496, 1024, (bf16_t*)(ws + WS_WIN), 1024, (r % 16) * 64, (r / 16) * 32, a.in[2], lane); continue; } r -= J_WIN;
        if (r < J_SQ) { tr_item<0>(a.in[7], 1024, 1024, (bf16_t*)(ws + WS_WGR), 1024, (r % 16) * 64, (r / 16) * 32, nullptr, lane); continue; } r -= J_SQ;
        if (r < J_SQ) { tr_item<0>(a.in[24], 1024, 1024, (bf16_t*)(ws + WS_WGR) + 1024 * 1024, 1024, (r % 16) * 64, (r / 16) * 32, nullptr, lane); continue; } r -= J_SQ;
        tr_item<0>(a.in[25], 1024, 1024, (bf16_t*)(ws + WS_WOUT), 1024, (r % 16) * 64, (r / 16) * 32, nullptr, lane);
    }
    bf16_t* XB = (bf16_t*)(ws + WS_XB);
    for (int row = gw; row < TR; row += NGW) {
        const f32x4* srcp = (const f32x4*)(a.in[0] + (size_t)row * D);
        f32x4 v[2][2]; float s = 0.f;
#pragma unroll
        for (int j = 0; j < 2; ++j)
#pragma unroll
            for (int h = 0; h < 2; ++h) { v[j][h] = srcp[2 * (lane + 64 * j) + h]; s += (v[j][h].x * v[j][h].x + v[j][h].y * v[j][h].y) + (v[j][h].z * v[j][h].z + v[j][h].w * v[j][h].w); }
        const float rstd = rsqrtf(wave_sum(s) * (1.0f / D) + EPS);
#pragma unroll
        for (int j = 0; j < 2; ++j) *(u32x4*)(XB + (size_t)row * D + 8 * (lane + 64 * j)) =
            (u32x4){pk2(v[j][0].x * rstd, v[j][0].y * rstd), pk2(v[j][0].z * rstd, v[j][0].w * rstd), pk2(v[j][1].x * rstd, v[j][1].y * rstd), pk2(v[j][1].z * rstd, v[j][1].w * rstd)};
    }
    __syncthreads();
    LAS float* UM = (LAS float*)lds;
    LAS float* RED = UM + 1024 * 16;
    { const float* gmix = a.in[2];
#pragma unroll
      for (int rr = 0; rr < 2; ++rr) { const int l = wave * 2 + rr; const float* srcp = a.in[1] + (size_t)l * D; float x[16]; float s = 0.f;
#pragma unroll
          for (int m = 0; m < 16; ++m) { x[m] = srcp[lane + 64 * m]; s += x[m] * x[m]; }
          const float rstd = rsqrtf(wave_sum(s) * (1.0f / D) + EPS);
#pragma unroll
          for (int m = 0; m < 16; ++m) { const int k = lane + 64 * m; UM[k * 16 + l] = x[m] * rstd * gmix[k]; } } }
    __syncthreads();
    bf16_t* P = (bf16_t*)(ws + WS_P);
    for (int cg = blockIdx.x; cg < 256; cg += gridDim.x) {
        const int n0 = cg * 34, kq = tid >> 5, c = tid & 31;
        const int sA = win_srccol(n0 + c), sB = (c < 2) ? win_srccol(n0 + 32 + c) : -1;
        float accA[16], accB[16];
#pragma unroll
        for (int l = 0; l < 16; ++l) { accA[l] = 0.f; accB[l] = 0.f; }
#pragma unroll 4
        for (int k = kq; k < 1024; k += 16) {
            const float wA = (sA >= 0) ? a.in[3][(size_t)k * 8496 + sA] : 0.f, wB = (sB >= 0) ? a.in[3][(size_t)k * 8496 + sB] : 0.f;
            const f32x4 u0 = *(const LAS f32x4*)(UM + k * 16), u1 = *(const LAS f32x4*)(UM + k * 16 + 4), u2 = *(const LAS f32x4*)(UM + k * 16 + 8), u3 = *(const LAS f32x4*)(UM + k * 16 + 12);
#pragma unroll
            for (int j = 0; j < 4; ++j) { accA[j] += u0[j] * wA; accA[4 + j] += u1[j] * wA; accA[8 + j] += u2[j] * wA; accA[12 + j] += u3[j] * wA;
                                          accB[j] += u0[j] * wB; accB[4 + j] += u1[j] * wB; accB[8 + j] += u2[j] * wB; accB[12 + j] += u3[j] * wB; }
        }
#pragma unroll
        for (int l = 0; l < 16; ++l) { RED[(kq * 34 + c) * 16 + l] = accA[l]; if (c < 2) RED[(kq * 34 + 32 + c) * 16 + l] = accB[l]; }
        __syncthreads();
        for (int o = tid; o < 34 * 16; o += 512) { const int cc = o >> 4, l = o & 15; float s = 0.f;
#pragma unroll
            for (int q = 0; q < 16; ++q) s += RED[(q * 34 + cc) * 16 + l];
            P[(size_t)(MROW + l) * LDP + n0 + cc] = (bf16_t)f2bf(s); }
        __syncthreads();
    }
}

constexpr float LORA_SCALE = 16.0f;
__device__ __forceinline__ float fp8_byte(int w, int b) { return b == 0 ? __builtin_amdgcn_cvt_f32_fp8(w, 0) : (b == 1 ? __builtin_amdgcn_cvt_f32_fp8(w, 1) : (b == 2 ? __builtin_amdgcn_cvt_f32_fp8(w, 2) : __builtin_amdgcn_cvt_f32_fp8(w, 3))); }
struct LoraW { bf16x8 w[2][2], a[2][2], g[2][6]; };
__device__ __forceinline__ void lora_ldw(LoraW& F, const bf16_t* WFR, int p, int lane) {
#pragma unroll
    for (int u = 0; u < 2; ++u) { const bf16x8* b = (const bf16x8*)WFR + (size_t)((p * 2 + u) * 10) * 64 + lane;
#pragma unroll
        for (int ks = 0; ks < 2; ++ks) { F.w[u][ks] = b[ks * 64]; F.a[u][ks] = b[(2 + ks) * 64]; }
#pragma unroll
        for (int ks = 0; ks < 6; ++ks) F.g[u][ks] = b[(4 + ks) * 64]; }
}
__device__ __forceinline__ void phase_lora(const Args& a, LAS unsigned char* lds) {
    const int tid = tidx(), wave = tid >> 6, lane = tid & 63, fr = lane & 15, fq = lane >> 4;
    const bf16_t* P = (const bf16_t*)(a.ws + WS_P);
    const bf16_t* WFR = (const bf16_t*)(a.ws + WS_WFR);
    bf16_t* WLIN = (bf16_t*)(a.ws + WS_LORA); bf16_t* AGLIN = (bf16_t*)(a.ws + WS_LORA + LSLOT);
    LAS bf16_t* Xw = (LAS bf16_t*)lds; LAS bf16_t* Xa = Xw + 128 * 72; LAS bf16_t* Xg = Xa + 128 * 72;
    const float* mu_w = a.in[11]; const float* mu_a = a.in[12]; const float* mu_g = a.in[13];
    {
        const unsigned char* wsrc = (const unsigned char*)WFR + (size_t)wave * (4 * 2 * 10 * 1024) + lane * 16;
        LAS unsigned* dump = (LAS unsigned*)(lds + 122880 + wave * 1024);
        for (int q = 0; q < 80; ++q) __builtin_amdgcn_global_load_lds((const unsigned*)(wsrc + q * 1024), dump, 16, 0, 0); }
    for (int tile = blockIdx.x; tile <= TR / 128; tile += gridDim.x) {
        const bool meta = (tile == TR / 128);
        { const int rr = tid >> 2, qd = tid & 3;
          int t, tp;
          if (!meta) { t = tile * 128 + rr; tp = (t & (SEQ - 1)) ? t - 1 : MROW + NMETA - 1; }
          else { t = MROW + (rr & 15); tp = (rr & 15) ? t - 1 : -1; }
          const bool hp = tp >= 0;
          const bf16_t* cur = P + (size_t)t * LDP; const bf16_t* prv = P + (size_t)(hp ? tp : t) * LDP;
#pragma unroll
          for (int hf = 0; hf < 2; ++hf) { const int c = qd * 16 + hf * 8;
              { const u32x4 vc = *(const u32x4*)(cur + C_RW + c); u32x4 vp = (u32x4){0u, 0u, 0u, 0u}; if (hp) vp = *(const u32x4*)(prv + C_RW + c);
                float z[8]; const unsigned wc_[4] = {vc.x, vc.y, vc.z, vc.w}, wp_[4] = {vp.x, vp.y, vp.z, vp.w};
#pragma unroll
                for (int j = 0; j < 4; ++j) { const float c0 = bf_lo(wc_[j]), c1 = bf_hi(wc_[j]), p0 = bf_lo(wp_[j]), p1 = bf_hi(wp_[j]);
                    z[2 * j] = tanhf_(c0 + (p0 - c0) * mu_w[c + 2 * j]); z[2 * j + 1] = tanhf_(c1 + (p1 - c1) * mu_w[c + 2 * j + 1]); }
                *(LAS u32x4*)(Xw + rr * 72 + c) = (u32x4){pk2(z[0], z[1]), pk2(z[2], z[3]), pk2(z[4], z[5]), pk2(z[6], z[7])}; }
              { const u32x4 vc = *(const u32x4*)(cur + C_RA + c); u32x4 vp = (u32x4){0u, 0u, 0u, 0u}; if (hp) vp = *(const u32x4*)(prv + C_RA + c);
                float z[8]; const unsigned wc_[4] = {vc.x, vc.y, vc.z, vc.w}, wp_[4] = {vp.x, vp.y, vp.z, vp.w};
#pragma unroll
                for (int j = 0; j < 4; ++j) { const float c0 = bf_lo(wc_[j]), c1 = bf_hi(wc_[j]), p0 = bf_lo(wp_[j]), p1 = bf_hi(wp_[j]);
                    z[2 * j] = c0 + (p0 - c0) * mu_a[c + 2 * j]; z[2 * j + 1] = c1 + (p1 - c1) * mu_a[c + 2 * j + 1]; }
                *(LAS u32x4*)(Xa + rr * 72 + c) = (u32x4){pk2(z[0], z[1]), pk2(z[2], z[3]), pk2(z[4], z[5]), pk2(z[6], z[7])}; } }
#pragma unroll
          for (int ch = 0; ch < 5; ++ch) { const int c = qd * 40 + ch * 8;
              const u32x4 vc = *(const u32x4*)(cur + C_RG + c); u32x4 vp = (u32x4){0u, 0u, 0u, 0u}; if (hp) vp = *(const u32x4*)(prv + C_RG + c);
              float z[8]; const unsigned wc_[4] = {vc.x, vc.y, vc.z, vc.w}, wp_[4] = {vp.x, vp.y, vp.z, vp.w};
#pragma unroll
              for (int j = 0; j < 4; ++j) { const float c0 = bf_lo(wc_[j]), c1 = bf_hi(wc_[j]), p0 = bf_lo(wp_[j]), p1 = bf_hi(wp_[j]);
                  z[2 * j] = sigmoidf_(c0 + (p0 - c0) * mu_g[c + 2 * j]); z[2 * j + 1] = sigmoidf_(c1 + (p1 - c1) * mu_g[c + 2 * j + 1]); }
              *(LAS u32x4*)(Xg + rr * 200 + c) = (u32x4){pk2(z[0], z[1]), pk2(z[2], z[3]), pk2(z[4], z[5]), pk2(z[6], z[7])}; }
          *(LAS u32x4*)(Xg + rr * 200 + 160 + qd * 8) = (u32x4){0u, 0u, 0u, 0u};
        }
        __syncthreads();
        const int ngrp = meta ? 1 : 8;
        for (int pp = 0; pp < 4; ++pp) { const int p = wave * 4 + pp;
            LoraW F; lora_ldw(F, WFR, p, lane);
            for (int mg = 0; mg < ngrp; ++mg) { const int m0 = mg * 16;
                f32x4 cw[2], ca[2], cg[2];
#pragma unroll
                for (int u = 0; u < 2; ++u) { cw[u] = (f32x4){0.f, 0.f, 0.f, 0.f}; ca[u] = cw[u]; cg[u] = cw[u]; }
#pragma unroll
                for (int ks = 0; ks < 2; ++ks) { const bf16x8 xw = *(const LAS bf16x8*)(Xw + (m0 + fr) * 72 + ks * 32 + fq * 8), xa = *(const LAS bf16x8*)(Xa + (m0 + fr) * 72 + ks * 32 + fq * 8);
#pragma unroll
                    for (int u = 0; u < 2; ++u) { cw[u] = __builtin_amdgcn_mfma_f32_16x16x32_bf16(F.w[u][ks], xw, cw[u], 0, 0, 0); ca[u] = __builtin_amdgcn_mfma_f32_16x16x32_bf16(F.a[u][ks], xa, ca[u], 0, 0, 0); } }
#pragma unroll
                for (int ks = 0; ks < 6; ++ks) { const bf16x8 xg = *(const LAS bf16x8*)(Xg + (m0 + fr) * 200 + ks * 32 + fq * 8);
#pragma unroll
                    for (int u = 0; u < 2; ++u) cg[u] = __builtin_amdgcn_mfma_f32_16x16x32_bf16(F.g[u][ks], xg, cg[u], 0, 0, 0); }
                const size_t orow = (size_t)((meta ? MROW : tile * 128) + m0 + fr) * D; const int oc = 32 * p + 8 * fq;
                *(u32x4*)(WLIN + orow + oc) = (u32x4){pk2(cw[0][0], cw[0][1]), pk2(cw[0][2], cw[0][3]), pk2(cw[1][0], cw[1][1]), pk2(cw[1][2], cw[1][3])};
                { u32x4 w;
#pragma unroll
                  for (int u = 0; u < 2; ++u) { float oa[4], og[4];
#pragma unroll
                      for (int j = 0; j < 4; ++j) { oa[j] = __builtin_amdgcn_fmed3f(ca[u][j] * LORA_SCALE, -440.0f, 440.0f); og[j] = __builtin_amdgcn_fmed3f(cg[u][j] * LORA_SCALE, -440.0f, 440.0f); }
                      int pa = __builtin_amdgcn_cvt_pk_fp8_f32(oa[0], oa[1], 0, false); pa = __builtin_amdgcn_cvt_pk_fp8_f32(oa[2], oa[3], pa, true);
                      int pg = __builtin_amdgcn_cvt_pk_fp8_f32(og[0], og[1], 0, false); pg = __builtin_amdgcn_cvt_pk_fp8_f32(og[2], og[3], pg, true);
                      w[u] = (unsigned)pa; w[2 + u] = (unsigned)pg; }
                  *(u32x4*)(AGLIN + orow + oc) = w; }
            }
        }
        __syncthreads();
    }
}

__device__ __forceinline__ int swzf(int row) { return ((row >> 1) & 7) ^ ((row >> 4) & 7); }
__device__ __forceinline__ int swz(int row, int col) { return row * 64 + ((((col >> 3) ^ swzf(row)) << 3) | (col & 7)); }
__device__ __forceinline__ bf16x8 ldfrag(const LAS bf16_t* M, int row, int kchunk) { return *(const LAS bf16x8*)(M + row * 64 + ((kchunk ^ swzf(row)) << 3)); }
__device__ __forceinline__ float frcp(float x) { return __builtin_amdgcn_rcpf(x); }
struct FragOff { int o0, o1; };
__device__ __forceinline__ FragOff mkfo(int T, int fr, int X) { FragOff f; f.o0 = T * 1024 + fr * 64 + (((T ^ X) & 7) << 3); f.o1 = f.o0 ^ 32; return f; }
#define LDF(M, fo, ks) (*(const LAS bf16x8*)((M) + ((ks) ? (fo).o1 : (fo).o0)))
#define LDF2(M, fo, ks) (*(const LAS bf16x8*)((M) + ((ks) >> 1) * 4096 + (((ks) & 1) ? (fo).o1 : (fo).o0)))

__device__ __forceinline__ void rwkv_item(const Args& a, LAS unsigned char* lds, int item) {
    const int tid = tidx(), wave = __builtin_amdgcn_readfirstlane(tid >> 6), lane = tid & 63, fr = lane & 15, fq = lane >> 4;
    const int b = item >> 4, h = item & 15;
    LAS bf16_t* ZA = (LAS bf16_t*)lds;
    LAS bf16_t* ZR = ZA + 4096;
    LAS bf16_t* XBm = ZR + 4096;
    LAS bf16_t* XK = XBm + 4096;
    LAS bf16_t* BTt = XK + 4096;
    LAS bf16_t* KTt = BTt + 4096;
    LAS bf16_t* VcT = KTt + 4096;
    LAS bf16_t* MakT = VcT + 4096;
    LAS bf16_t* NbrT = MakT + 4096;
    LAS bf16_t* NkrT = NbrT + 4096;
    LAS bf16_t* TIv = NkrT + 4096;
    LAS bf16_t* S0b = TIv + 4096;
    LAS bf16_t* U0b = S0b + 4096;
    LAS bf16_t* Ub = U0b + 4096;
    LAS float* CW = (LAS float*)(lds + 14 * 8192);
    LAS float* PTs = CW + 4096;
    LAS float* WCv = PTs + 512;
    LAS float* CST = WCv + 64;
    LAS bf16_t* PAb = (LAS bf16_t*)(CST + 640);
    LAS bf16_t* MA = U0b; LAS bf16_t* MAT = Ub; LAS bf16_t* MB = (LAS bf16_t*)CW; LAS bf16_t* MBT = MB + 4096;
    const bf16_t* P = (const bf16_t*)(a.ws + WS_P);
    const bf16_t* WLIN = (const bf16_t*)(a.ws + WS_LORA); const bf16_t* AGLIN = (const bf16_t*)(a.ws + WS_LORA + LSLOT);
    bf16_t* A12 = (bf16_t*)(a.ws + WS_R5);
    const int ptt = tid >> 3, c8 = (tid & 7) * 8, col = h * 64 + c8;
    if (tid < 64) { const int cc = h * 64 + tid;
        CST[tid] = a.in[8][cc]; CST[64 + tid] = a.in[9][cc]; CST[128 + tid] = a.in[10][cc]; CST[192 + tid] = a.in[15][cc]; CST[256 + tid] = a.in[17][cc];
        CST[320 + tid] = a.in[19][cc]; CST[384 + tid] = a.in[20][cc]; CST[448 + tid] = a.in[21][cc]; CST[512 + tid] = a.in[22][cc]; CST[576 + tid] = a.in[23][cc]; }
#define CSTV(arr, idx) float arr[8]; { const f32x4 c0_ = *(const LAS f32x4*)(CST + (idx) * 64 + c8), c1_ = *(const LAS f32x4*)(CST + (idx) * 64 + c8 + 4); \
        arr[0] = c0_[0]; arr[1] = c0_[1]; arr[2] = c0_[2]; arr[3] = c0_[3]; arr[4] = c1_[0]; arr[5] = c1_[1]; arr[6] = c1_[2]; arr[7] = c1_[3]; }
    f32x4 st[2]; st[0] = (f32x4){0.f, 0.f, 0.f, 0.f}; st[1] = st[0];
    for (int i = tid; i < 2048; i += 512) ((LAS unsigned*)S0b)[i] = 0u;
    for (int i = tid; i < 4 * 2048; i += 512) ((LAS unsigned*)MakT)[i] = 0u;
    const int ii = wave >> 1, tb = 2 * (wave & 1);
    const u32x4 z4 = (u32x4){0u, 0u, 0u, 0u};
    u32x4 Lr, Lk, Lv, Lrp, Lkp, Lvp, Lw, La;
#define RW_LOAD(nn) do { const int l_ = (nn) * 64 + ptt; const bool v_ = l_ < L; const bool hp_ = v_ && l_ > 0; \
        Lr = z4; Lk = z4; Lv = z4; Lrp = z4; Lkp = z4; Lvp = z4; Lw = z4; La = z4; \
        if (v_) { const size_t r_ = (size_t)prow(b, l_); const bf16_t* pc = P + r_ * LDP + col; const size_t lo = r_ * D + col; \
            Lr = *(const u32x4*)(pc + C_RR); Lk = *(const u32x4*)(pc + C_RK); Lv = *(const u32x4*)(pc + C_RV); \
            Lw = *(const u32x4*)(WLIN + lo); La = *(const u32x4*)(AGLIN + lo); } \
        if (hp_) { const bf16_t* pp = P + (size_t)prow(b, l_ - 1) * LDP + col; Lrp = *(const u32x4*)(pp + C_RR); Lkp = *(const u32x4*)(pp + C_RK); Lvp = *(const u32x4*)(pp + C_RV); } } while (0)
    RW_LOAD(0);
    __syncthreads();
#define LDS_BAR() do { asm volatile("s_waitcnt lgkmcnt(0)" ::: "memory"); __builtin_amdgcn_s_barrier(); asm volatile("" ::: "memory"); } while (0)
#define CVT1(x) ((bf16_t)f2bf(x))
#define CVT4(v0, v1, v2, v3) ((u32x2){pk2((v0), (v1)), pk2((v2), (v3))})
    const int tid_outer = tid;
    for (int n = 0; n < 65; ++n) {
        int tid = tid_outer; asm volatile("" : "+v"(tid));
        const int lane = tid & 63, fr = lane & 15, fq = lane >> 4, ptt = tid >> 3, c8 = (tid & 7) * 8, tk = lane >> 3;
        const int fX = (fq ^ (fr >> 1)) & 7; const FragOff fI = mkfo(ii, fr, fX); const FragOff fT[2] = {mkfo(tb, fr, fX), mkfo(tb + 1, fr, fX)};
        const int l = n * 64 + ptt; const bool valid = l < L;
        float r[8], km[8], v[8], av[8], bv[8], g[8], lw[8], cwv[8], bonus;
        {
            const unsigned wr_[4] = {Lr.x, Lr.y, Lr.z, Lr.w}, wrp[4] = {Lrp.x, Lrp.y, Lrp.z, Lrp.w}, wk_[4] = {Lk.x, Lk.y, Lk.z, Lk.w}, wkp[4] = {Lkp.x, Lkp.y, Lkp.z, Lkp.w};
            const unsigned wv_[4] = {Lv.x, Lv.y, Lv.z, Lv.w}, wvp[4] = {Lvp.x, Lvp.y, Lvp.z, Lvp.w}, ww_[4] = {Lw.x, Lw.y, Lw.z, Lw.w};
            const int wa8[2] = {(int)La.x, (int)La.y}, wg8[2] = {(int)La.z, (int)La.w};
            float k[8], asg[8], kkv[8]; float nrm = 0.f;
            CSTV(mur, 0) CSTV(muk, 1) CSTV(muv, 2) CSTV(bdec, 3) CSTV(ba, 4) CSTV(kkc, 5)
#pragma unroll
            for (int e = 0; e < 8; ++e) { const int q = e >> 1; const bool hi_ = e & 1;
                const float rc = hi_ ? bf_hi(wr_[q]) : bf_lo(wr_[q]), rp = hi_ ? bf_hi(wrp[q]) : bf_lo(wrp[q]);
                const float kc = hi_ ? bf_hi(wk_[q]) : bf_lo(wk_[q]), kp = hi_ ? bf_hi(wkp[q]) : bf_lo(wkp[q]);
                const float vc = hi_ ? bf_hi(wv_[q]) : bf_lo(wv_[q]), vp = hi_ ? bf_hi(wvp[q]) : bf_lo(wvp[q]);
                const float wl = hi_ ? bf_hi(ww_[q]) : bf_lo(ww_[q]), al = fp8_byte(wa8[e >> 2], e & 3) * (1.0f / LORA_SCALE);
                g[e] = fp8_byte(wg8[e >> 2], e & 3) * (1.0f / LORA_SCALE);
                r[e] = rc + (rp - rc) * mur[e]; k[e] = kc + (kp - kc) * muk[e]; v[e] = vc + (vp - vc) * muv[e];
                lw[e] = valid ? -0.6065306597126334f * frcp(1.0f + __expf(-(bdec[e] + wl))) : 0.f;
                asg[e] = frcp(1.0f + __expf(-(ba[e] + al)));
                kkv[e] = k[e] * kkc[e]; nrm += kkv[e] * kkv[e]; }
            nrm = red8(nrm);
            const float inv = rsqrtf(fmaxf(nrm, 1e-24f));
            float bn = 0.f;
            CSTV(kac, 6) CSTV(rkc, 7)
#pragma unroll
            for (int e = 0; e < 8; ++e) { const float kkn = kkv[e] * inv; km[e] = k[e] * (1.0f + (asg[e] - 1.0f) * kac[e]); av[e] = -kkn; bv[e] = kkn * asg[e]; bn += r[e] * km[e] * rkc[e]; }
            bonus = red8(bn);
#pragma unroll
            for (int e = 0; e < 8; ++e) { float x = lw[e];
                float y = __shfl_up(x, 8); x += (tk >= 1) ? y : 0.f;
                y = __shfl_up(x, 16); x += (tk >= 2) ? y : 0.f;
                y = __shfl_up(x, 32); x += (tk >= 4) ? y : 0.f;
                cwv[e] = x; }
            if (tk == 7) { *(LAS f32x4*)(PTs + wave * 64 + c8) = (f32x4){cwv[0], cwv[1], cwv[2], cwv[3]}; *(LAS f32x4*)(PTs + wave * 64 + c8 + 4) = (f32x4){cwv[4], cwv[5], cwv[6], cwv[7]}; }
        }
#pragma unroll
        for (int e = 0; e < 8; ++e) VcT[swz(c8 + e, ptt)] = CVT1(v[e]);
        LDS_BAR();
        { for (int p = 0; p < wave; ++p) { const f32x4 p0 = *(const LAS f32x4*)(PTs + p * 64 + c8), p1 = *(const LAS f32x4*)(PTs + p * 64 + c8 + 4);
#pragma unroll
              for (int e = 0; e < 4; ++e) { cwv[e] += p0[e]; cwv[4 + e] += p1[e]; } }
          float za[8], zr[8], xb[8], xk[8];
#pragma unroll
          for (int e = 0; e < 8; ++e) { const float ew = __expf(cwv[e]), ei = frcp(ew), ep = __expf(cwv[e] - lw[e]);
              za[e] = av[e] * ep; zr[e] = r[e] * ew; xb[e] = bv[e] * ei; xk[e] = km[e] * ei;
              if (ptt == 63) WCv[c8 + e] = ew; }
          const int so = swz(ptt, c8);
          { const u32x2 a0 = CVT4(za[0], za[1], za[2], za[3]), a1 = CVT4(za[4], za[5], za[6], za[7]); *(LAS u32x4*)(ZA + so) = (u32x4){a0.x, a0.y, a1.x, a1.y}; }
          { const u32x2 a0 = CVT4(zr[0], zr[1], zr[2], zr[3]), a1 = CVT4(zr[4], zr[5], zr[6], zr[7]); *(LAS u32x4*)(ZR + so) = (u32x4){a0.x, a0.y, a1.x, a1.y}; }
          { const u32x2 a0 = CVT4(xb[0], xb[1], xb[2], xb[3]), a1 = CVT4(xb[4], xb[5], xb[6], xb[7]); *(LAS u32x4*)(XBm + so) = (u32x4){a0.x, a0.y, a1.x, a1.y}; }
          { const u32x2 a0 = CVT4(xk[0], xk[1], xk[2], xk[3]), a1 = CVT4(xk[4], xk[5], xk[6], xk[7]); *(LAS u32x4*)(XK + so) = (u32x4){a0.x, a0.y, a1.x, a1.y}; }
#pragma unroll
          for (int e = 0; e < 8; ++e) { BTt[swz(c8 + e, ptt)] = CVT1(xb[e]); KTt[swz(c8 + e, ptt)] = CVT1(xk[e]); } }
        if (n + 1 < 65) RW_LOAD(n + 1);
        LDS_BAR();
        f32x4 u0[2], cy[2];
        if (wave < 2) {
            const int bb = wave, kx = bb << 5, hsel = fq >> 1;
            const FragOff fB[2] = {mkfo(2 * bb, fr, fX), mkfo(2 * bb + 1, fr, fX)};
            const bf16x8 zf = (bf16x8){0, 0, 0, 0, 0, 0, 0, 0};
#define HALF(v, d) ((hsel == (d)) ? (v) : zf)
#define BFR(Mx, e_) (*(const LAS bf16x8*)((Mx) + (fB[e_].o0 ^ kx)))
#define WL_FENCE() asm volatile("s_waitcnt lgkmcnt(0)" ::: "memory")
            f32x4 pt[2];
            {   bf16x8 za[2][2], xb[2][2];
#pragma unroll
                for (int e_ = 0; e_ < 2; ++e_)
#pragma unroll
                    for (int ks = 0; ks < 2; ++ks) { za[e_][ks] = LDF(ZA, fB[e_], ks); xb[e_][ks] = LDF(XBm, fB[e_], ks); }
#pragma unroll
                for (int d = 0; d < 2; ++d) { f32x4 c = (f32x4){0.f, 0.f, 0.f, 0.f};
#pragma unroll
                    for (int ks = 0; ks < 2; ++ks) c = __builtin_amdgcn_mfma_f32_16x16x32_bf16(za[d][ks], xb[d][ks], c, 0, 0, 0);
                    const int s = (2 * bb + d) * 16 + fr, t0 = (2 * bb + d) * 16 + 4 * fq; float m[4];
#pragma unroll
                    for (int r4 = 0; r4 < 4; ++r4) { m[r4] = (s < t0 + r4) ? c[r4] : 0.f; c[r4] = m[r4] + ((s == t0 + r4) ? 1.f : 0.f); }
                    pt[d] = c;
                    *(LAS u32x2*)(MA + swz(s, t0)) = CVT4(m[0], m[1], m[2], m[3]);
#pragma unroll
                    for (int r4 = 0; r4 < 4; ++r4) MAT[swz(t0 + r4, s)] = CVT1(m[r4]);
                    *(LAS u32x2*)(TIv + swz(s, t0)) = CVT4(c[0], c[1], c[2], c[3]); }
                {   f32x4 c = (f32x4){0.f, 0.f, 0.f, 0.f};
#pragma unroll
                    for (int ks = 0; ks < 2; ++ks) c = __builtin_amdgcn_mfma_f32_16x16x32_bf16(za[1][ks], xb[0][ks], c, 0, 0, 0);
                    *(LAS u32x2*)(MA + swz(2 * bb * 16 + fr, (2 * bb + 1) * 16 + 4 * fq)) = CVT4(c[0], c[1], c[2], c[3]); } }
#define INV_SQ(Mc, McT, Mn, MnT) do { _Pragma("unroll") for (int d = 0; d < 2; ++d) { \
                    const f32x4 q_ = __builtin_amdgcn_mfma_f32_16x16x32_bf16(HALF(BFR(Mc, d), d), HALF(BFR(McT, d), d), (f32x4){0.f, 0.f, 0.f, 0.f}, 0, 0, 0);     \
                    const int t_ = (2 * bb + d) * 16 + fr, s0_ = (2 * bb + d) * 16 + 4 * fq; \
                    *(LAS u32x2*)((MnT) + swz(t_, s0_)) = CVT4(q_[0], q_[1], q_[2], q_[3]); \
                    _Pragma("unroll") for (int r4 = 0; r4 < 4; ++r4) (Mn)[swz(s0_ + r4, t_)] = CVT1(q_[r4]); } } while (0)
#define INV_PU(McT, Pc, Pn) do { _Pragma("unroll") for (int d = 0; d < 2; ++d) { \
                    pt[d] = __builtin_amdgcn_mfma_f32_16x16x32_bf16(HALF(BFR(McT, d), d), HALF(BFR(Pc, d), d), pt[d], 0, 0, 0);                                   \
                    *(LAS u32x2*)((Pn) + swz((2 * bb + d) * 16 + fr, (2 * bb + d) * 16 + 4 * fq)) = CVT4(pt[d][0], pt[d][1], pt[d][2], pt[d][3]); } } while (0)
            WL_FENCE(); INV_SQ(MA, MAT, MB, MBT);
            WL_FENCE(); INV_PU(MBT, TIv, PAb); INV_SQ(MB, MBT, MA, MAT);
            WL_FENCE(); INV_PU(MAT, PAb, TIv); INV_SQ(MA, MAT, MB, MBT);
            WL_FENCE(); INV_PU(MBT, TIv, PAb);
#pragma unroll
            for (int d = 0; d < 2; ++d) {
#pragma unroll
                for (int r4 = 0; r4 < 4; ++r4) TIv[swz((2 * bb + d) * 16 + 4 * fq + r4, (2 * bb + d) * 16 + fr)] = CVT1(pt[d][r4]); }
            WL_FENCE();
            {
                const f32x4 c = __builtin_amdgcn_mfma_f32_16x16x32_bf16(HALF(BFR(MA, 0), 1), HALF(BFR(TIv, 1), 1), (f32x4){0.f, 0.f, 0.f, 0.f}, 0, 0, 0);
                *(LAS u32x2*)(PAb + swz((2 * bb + 1) * 16 + fr, 2 * bb * 16 + 4 * fq)) = CVT4(c[0], c[1], c[2], c[3]); }
            WL_FENCE();
            {
                const f32x4 c = __builtin_amdgcn_mfma_f32_16x16x32_bf16(HALF(BFR(PAb, 1), 0), HALF(BFR(PAb, 0), 0), (f32x4){0.f, 0.f, 0.f, 0.f}, 0, 0, 0);
#pragma unroll
                for (int r4 = 0; r4 < 4; ++r4) TIv[swz((2 * bb + 1) * 16 + 4 * fq + r4, 2 * bb * 16 + fr)] = CVT1(c[r4]);
                if (bb == 0) {
                    *(LAS u32x2*)(MBT + swz(fr, 32 + 16 + 4 * fq)) = CVT4(c[0], c[1], c[2], c[3]);
                    *(LAS u32x2*)(MBT + swz(fr, 32 + 4 * fq)) = CVT4(pt[0][0], pt[0][1], pt[0][2], pt[0][3]);
                    *(LAS u32x2*)(MBT + swz(16 + fr, 32 + 16 + 4 * fq)) = CVT4(pt[1][0], pt[1][1], pt[1][2], pt[1][3]);
                    *(LAS u32x2*)(MBT + swz(16 + fr, 32 + 4 * fq)) = (u32x2){0u, 0u}; } }
#undef INV_SQ
#undef INV_PU
#undef WL_FENCE
#undef HALF
#undef BFR
        } else {
            const int wi = wave - 2;
            for (int Q = wi; Q < 34; Q += 6) {
                if (Q < 30) { const int mat = Q / 10, q10 = Q - mat * 10, ti = (q10 >= 6) ? 3 : ((q10 >= 3) ? 2 : ((q10 >= 1) ? 1 : 0)), si = q10 - (ti * (ti + 1)) / 2;
                    const LAS bf16_t* Xm = (mat == 1) ? XBm : XK; const LAS bf16_t* Zm = (mat == 0) ? ZA : ZR; LAS bf16_t* Om = (mat == 0) ? MakT : ((mat == 1) ? NbrT : NkrT);
                    f32x4 c = (f32x4){0.f, 0.f, 0.f, 0.f}; const FragOff fS_ = mkfo(si, fr, fX), fT_ = mkfo(ti, fr, fX);
#pragma unroll
                    for (int ks = 0; ks < 2; ++ks) c = __builtin_amdgcn_mfma_f32_16x16x32_bf16(LDF(Xm, fS_, ks), LDF(Zm, fT_, ks), c, 0, 0, 0);
                    const int t = ti * 16 + fr, s0 = si * 16 + 4 * fq; float o[4];
#pragma unroll
                    for (int r4 = 0; r4 < 4; ++r4) { const int s = s0 + r4; const bool keep = (mat == 0) ? (s < t) : (s <= t); o[r4] = keep ? c[r4] : 0.f; }
                    *(LAS u32x2*)(Om + swz(t, s0)) = CVT4(o[0], o[1], o[2], o[3]); }
                else { const int otl = 2 + ((Q - 30) >> 1), osl = (Q - 30) & 1; f32x4 c = (f32x4){0.f, 0.f, 0.f, 0.f}; const FragOff fOT = mkfo(otl, fr, fX), fOS = mkfo(osl, fr, fX);
#pragma unroll
                    for (int ks = 0; ks < 2; ++ks) c = __builtin_amdgcn_mfma_f32_16x16x32_bf16(LDF(ZA, fOT, ks), LDF(XBm, fOS, ks), c, 0, 0, 0);
                    *(LAS u32x2*)(MA + swz(osl * 16 + fr, otl * 16 + 4 * fq)) = CVT4(c[0], c[1], c[2], c[3]); } } }
        LDS_BAR();
#pragma unroll
        for (int u = 0; u < 2; ++u) { f32x4 c = (f32x4){0.f, 0.f, 0.f, 0.f};
#pragma unroll
            for (int ks = 0; ks < 2; ++ks) c = __builtin_amdgcn_mfma_f32_16x16x32_bf16(LDF(ZA, fT[u], ks), LDF(S0b, fI, ks), c, 0, 0, 0);
#pragma unroll
            for (int ks = 0; ks < 2; ++ks) c = __builtin_amdgcn_mfma_f32_16x16x32_bf16(LDF(MakT, fT[u], ks), LDF(VcT, fI, ks), c, 0, 0, 0);
            u0[u] = c; }
#pragma unroll
        for (int u = 0; u < 2; ++u) { f32x4 c = (f32x4){0.f, 0.f, 0.f, 0.f};
#pragma unroll
            for (int ks = 0; ks < 2; ++ks) c = __builtin_amdgcn_mfma_f32_16x16x32_bf16(LDF(S0b, fI, ks), LDF(ZR, fT[u], ks), c, 0, 0, 0);
#pragma unroll
            for (int ks = 0; ks < 2; ++ks) c = __builtin_amdgcn_mfma_f32_16x16x32_bf16(LDF(VcT, fI, ks), LDF(NkrT, fT[u], ks), c, 0, 0, 0);
            cy[u] = c; }
#pragma unroll
        for (int u = 0; u < 2; ++u) {
#pragma unroll
            for (int ks = 0; ks < 2; ++ks) st[u] = __builtin_amdgcn_mfma_f32_16x16x32_bf16(LDF(VcT, fI, ks), LDF(KTt, fT[u], ks), st[u], 0, 0, 0); }
        if (wave < 4) { const int xsl = wave >> 1, xtl = 2 + (wave & 1);
            const f32x4 c = __builtin_amdgcn_mfma_f32_16x16x32_bf16(LDF(MA, mkfo(xsl, fr, fX), 1), LDF(TIv, mkfo(xtl, fr, fX), 1), (f32x4){0.f, 0.f, 0.f, 0.f}, 0, 0, 0);
            *(LAS u32x2*)(MB + swz(xtl * 16 + fr, xsl * 16 + 4 * fq)) = CVT4(c[0], c[1], c[2], c[3]); }
        LDS_BAR();
        if (wave < 4) { const int ntl = 2 + (wave >> 1), nsl = wave & 1;
            const f32x4 c = __builtin_amdgcn_mfma_f32_16x16x32_bf16(LDF(MB, mkfo(ntl, fr, fX), 0), LDF(MBT, mkfo(nsl, fr, fX), 1), (f32x4){0.f, 0.f, 0.f, 0.f}, 0, 0, 0);
#pragma unroll
            for (int r4 = 0; r4 < 4; ++r4) TIv[swz(ntl * 16 + 4 * fq + r4, nsl * 16 + fr)] = CVT1(c[r4]); }
#pragma unroll
        for (int u = 0; u < 2; ++u) *(LAS u32x2*)(U0b + swz(ii * 16 + fr, (tb + u) * 16 + 4 * fq)) = CVT4(u0[u][0], u0[u][1], u0[u][2], u0[u][3]);
        LDS_BAR();
#pragma unroll
        for (int u = 0; u < 2; ++u) { const int ti = tb + u; f32x4 c = (f32x4){0.f, 0.f, 0.f, 0.f};
#pragma unroll
            for (int ks = 0; ks < 2; ++ks) c = __builtin_amdgcn_mfma_f32_16x16x32_bf16(LDF(TIv, fT[u], ks), LDF(U0b, fI, ks), c, 0, 0, 0);
            *(LAS u32x2*)(Ub + swz(ii * 16 + fr, ti * 16 + 4 * fq)) = CVT4(c[0], c[1], c[2], c[3]); }
        LDS_BAR();
        LAS float* YB = CW;
#pragma unroll
        for (int u = 0; u < 2; ++u) { const int ti = tb + u;
#pragma unroll
            for (int ks = 0; ks < 2; ++ks) cy[u] = __builtin_amdgcn_mfma_f32_16x16x32_bf16(LDF(Ub, fI, ks), LDF(NbrT, fT[u], ks), cy[u], 0, 0, 0);
            *(LAS f32x4*)(YB + (ti * 16 + fr) * 64 + ii * 16 + 4 * fq) = cy[u]; }
#pragma unroll
        for (int u = 0; u < 2; ++u) { const int jt = tb + u;
#pragma unroll
            for (int ks = 0; ks < 2; ++ks) st[u] = __builtin_amdgcn_mfma_f32_16x16x32_bf16(LDF(Ub, fI, ks), LDF(BTt, fT[u], ks), st[u], 0, 0, 0);
            st[u] = st[u] * WCv[jt * 16 + fr];
#pragma unroll
            for (int r4 = 0; r4 < 4; ++r4) S0b[swz(ii * 16 + 4 * fq + r4, jt * 16 + fr)] = CVT1(st[u][r4]); }
        LDS_BAR();
        { const f32x4 y0 = *(const LAS f32x4*)(YB + ptt * 64 + c8), y1 = *(const LAS f32x4*)(YB + ptt * 64 + c8 + 4);
          float y[8];
#pragma unroll
          for (int e = 0; e < 4; ++e) { y[e] = y0[e]; y[4 + e] = y1[e]; }
          float sm = 0.f;
#pragma unroll
          for (int e = 0; e < 8; ++e) sm += y[e];
          const float mean = red8(sm) * (1.0f / 64.0f); float sq = 0.f;
#pragma unroll
          for (int e = 0; e < 8; ++e) { y[e] -= mean; sq += y[e] * y[e]; }
          const float rstd = rsqrtf(red8(sq) * (1.0f / 64.0f) + 64e-5f);
          CSTV(lng, 8) CSTV(lnb, 9)
          float o[8];
#pragma unroll
          for (int e = 0; e < 8; ++e) o[e] = (y[e] * rstd * lng[e] + lnb[e] + bonus * v[e]) * g[e];
          if (l >= NMETA && l < L) { const u32x2 a0 = CVT4(o[0], o[1], o[2], o[3]), a1 = CVT4(o[4], o[5], o[6], o[7]);
              *(u32x4*)(A12 + ((size_t)b * SEQ + (l - NMETA)) * 2048 + 1024 + col) = (u32x4){a0.x, a0.y, a1.x, a1.y}; } }
    }
    __syncthreads();
#undef LDS_BAR
#undef CVT1
#undef CVT4
#undef CSTV
#undef RW_LOAD

}

__device__ __forceinline__ void gla_item(const Args& a, LAS unsigned char* lds, int item) {
    const int tid0 = tidx(), wave = __builtin_amdgcn_readfirstlane(tid0 >> 6);
    const int b = item >> 4, h = (item >> 2) & 3, s = item & 3;
    LAS float* BL0 = (LAS float*)lds;
    LAS bf16_t* QT = (LAS bf16_t*)(BL0 + 128);
    LAS bf16_t* KT = QT + 8192;
    LAS bf16_t* QS0 = KT + 8192;
    LAS bf16_t* KDT = QS0 + 16384;
    LAS bf16_t* VT0 = KDT + 8192;
    LAS bf16_t* AM = VT0 + 8192;
    LAS bf16_t* STB0 = AM + 4096;
    bf16_t* P = (bf16_t*)(a.ws + WS_P);
    for (int i = tid0; i < 4096; i += 512) ((LAS unsigned*)STB0)[i] = 0u;
    const int lane0 = tid0 & 63, fr0 = lane0 & 15, fq0 = lane0 >> 4;
    bf16x8 w2f;
    { unsigned wv_[4] = {0u, 0u, 0u, 0u};
      if (fq0 < 2) {
#pragma unroll
          for (int j = 0; j < 4; ++j) wv_[j] = pk2(a.in[4][(8 * fq0 + 2 * j) * 512 + h * 128 + 16 * wave + fr0], a.in[4][(8 * fq0 + 2 * j + 1) * 512 + h * 128 + 16 * wave + fr0]); }
      w2f = __builtin_bit_cast(bf16x8, (u32x4){wv_[0], wv_[1], wv_[2], wv_[3]}); }
    const f32x4 b2v = *(const f32x4*)(a.in[5] + h * 128 + 16 * wave + 4 * fq0);
    f32x4 st[4];
#pragma unroll
    for (int dt = 0; dt < 4; ++dt) st[dt] = (f32x4){0.f, 0.f, 0.f, 0.f};
    const float qscale = 0.08838834764831845f;
    const u32x4 z4 = (u32x4){0u, 0u, 0u, 0u}; const u32x2 z2 = (u32x2){0u, 0u};
    u32x4 La[4], Lv; u32x2 Lq[4], Lk[4];
#define GL_LOAD(nn) do { Lv = z4; \
        _Pragma("unroll") for (int ti_ = 0; ti_ < 4; ++ti_) { const int l_ = (nn) * 64 - 48 + 16 * ti_ + fr0; La[ti_] = z4; Lq[ti_] = z2; Lk[ti_] = z2; \
            if (l_ >= 0) { const bf16_t* pr_ = P + (size_t)prow(b, l_) * LDP; if (fq0 < 2) La[ti_] = *(const u32x4*)(pr_ + C_GA + 8 * fq0); \
                Lq[ti_] = *(const u32x2*)(pr_ + C_GQ + h * 128 + 16 * wave + 4 * fq0); Lk[ti_] = *(const u32x2*)(pr_ + C_GK + h * 128 + 16 * wave + 4 * fq0); } } \
        { const int l_ = (nn) * 64 - 48 + (tid0 >> 3); if (l_ >= 0) Lv = *(const u32x4*)(P + (size_t)prow(b, l_) * LDP + C_GV + h * 256 + s * 64 + (tid0 & 7) * 8); } } while (0)
#define GL_BAR() do { asm volatile("s_waitcnt lgkmcnt(0)" ::: "memory"); __builtin_amdgcn_s_barrier(); asm volatile("" ::: "memory"); } while (0)
    GL_LOAD(0);
    __syncthreads();
    for (int n = 0; n < 65; ++n) {
        int tid = tid0; asm volatile("" : "+v"(tid));
        const int lane = tid & 63, fr = lane & 15, fq = lane >> 4, tl = tid >> 3;
        const int fX = (fq ^ (fr >> 1)) & 7; const FragOff fTi = mkfo(wave >> 1, fr, fX); const FragOff fJ[2] = {mkfo(2 * (wave & 1), fr, fX), mkfo(2 * (wave & 1) + 1, fr, fX)}; const FragOff fW = mkfo(wave, fr, fX);
        const int l0 = n * 64 - 48;
        LAS float* BL = BL0; LAS bf16_t* QS = QS0 + (n & 1) * 8192; LAS bf16_t* VT = VT0 + (n & 1) * 4096; LAS bf16_t* STBr = STB0 + (n & 1) * 8192; LAS bf16_t* STBw = STB0 + ((n + 1) & 1) * 8192;
        { f32x4 bt[4];
#pragma unroll
          for (int ti = 0; ti < 4; ++ti) { const bool valid = (l0 + 16 * ti + fr) >= 0;
              f32x4 x = __builtin_amdgcn_mfma_f32_16x16x32_bf16(w2f, __builtin_bit_cast(bf16x8, La[ti]), (f32x4){0.f, 0.f, 0.f, 0.f}, 0, 0, 0);
#pragma unroll
              for (int r = 0; r < 4; ++r) { const float xx = x[r] + b2v[r]; float gk = valid ? (fminf(xx, 0.f) - __logf(1.0f + __expf(-fabsf(xx)))) * (1.0f / 16.0f) : 0.f;
                  gk += dppf<0x111>(gk); gk += dppf<0x112>(gk); gk += dppf<0x114>(gk); gk += dppf<0x118>(gk);
                  x[r] = gk; }
              bt[ti] = x; }
          f32x4 bref, blast;
          { f32x4 run = (f32x4){0.f, 0.f, 0.f, 0.f};
#pragma unroll
            for (int ti = 0; ti < 4; ++ti) { f32x4 tot;
#pragma unroll
                for (int r = 0; r < 4; ++r) tot[r] = __shfl(bt[ti][r], 15, 16);
                bt[ti] = bt[ti] + run; run = run + tot; if (ti == 1) bref = run; }
            blast = run; }
          if (fr == 0) *(LAS f32x4*)(BL + 16 * wave + 4 * fq) = (f32x4){__expf(blast[0]), __expf(blast[1]), __expf(blast[2]), __expf(blast[3])};
          const int hf = wave >> 2, cq = (16 * wave + 4 * fq) & 63;
#pragma unroll
          for (int ti = 0; ti < 4; ++ti) { const int tt = 16 * ti + fr;
              const float qv[4] = {bf_lo(Lq[ti].x), bf_hi(Lq[ti].x), bf_lo(Lq[ti].y), bf_hi(Lq[ti].y)}, kv[4] = {bf_lo(Lk[ti].x), bf_hi(Lk[ti].x), bf_lo(Lk[ti].y), bf_hi(Lk[ti].y)};
              float qt[4], kt[4], qs[4];
#pragma unroll
              for (int r = 0; r < 4; ++r) { const float bb = bt[ti][r];
                  const float e1 = __expf(bb - bref[r]), e2 = __builtin_amdgcn_rcpf(e1), e3 = __expf(bb), e4 = __expf(blast[r] - bb);
                  qt[r] = qv[r] * qscale * e1; kt[r] = kv[r] * e2; qs[r] = qv[r] * qscale * e3;
                  KDT[swz(16 * wave + 4 * fq + r, tt)] = (bf16_t)f2bf(kv[r] * e4); }
              const int so = hf * 4096 + swz(tt, cq);
              *(LAS u32x2*)(QT + so) = (u32x2){pk2(qt[0], qt[1]), pk2(qt[2], qt[3])};
              *(LAS u32x2*)(KT + so) = (u32x2){pk2(kt[0], kt[1]), pk2(kt[2], kt[3])};
              *(LAS u32x2*)(QS + so) = (u32x2){pk2(qs[0], qs[1]), pk2(qs[2], qs[3])}; }
          const unsigned wv[4] = {Lv.x, Lv.y, Lv.z, Lv.w}; const int d8 = (tid & 7) * 8;
#pragma unroll
          for (int j = 0; j < 4; ++j) { VT[swz(d8 + 2 * j, tl)] = (bf16_t)(wv[j] & 0xffffu); VT[swz(d8 + 2 * j + 1, tl)] = (bf16_t)(wv[j] >> 16); } }
        if (n + 1 < 65) GL_LOAD(n + 1);
        GL_BAR();
        { const int ti = wave >> 1;
#pragma unroll
          for (int jj = 0; jj < 2; ++jj) { const int ji = 2 * (wave & 1) + jj; f32x4 c = (f32x4){0.f, 0.f, 0.f, 0.f};
              if (ji <= ti) {
#pragma unroll
                  for (int ks = 0; ks < 4; ++ks) c = __builtin_amdgcn_mfma_f32_16x16x32_bf16(LDF2(KT, fJ[jj], ks), LDF2(QT, fTi, ks), c, 0, 0, 0); }
              const int t = ti * 16 + fr, j0 = ji * 16 + 4 * fq;
              float o[4];
#pragma unroll
              for (int r = 0; r < 4; ++r) o[r] = (j0 + r <= t) ? c[r] : 0.f;
              *(LAS u32x2*)(AM + swz(t, j0)) = (u32x2){pk2(o[0], o[1]), pk2(o[2], o[3])}; } }
        GL_BAR();
        { const int ti = wave >> 1, l0t = l0 + ti * 16 + fr;
#pragma unroll
          for (int dd = 0; dd < 2; ++dd) { const int di = 2 * (wave & 1) + dd; f32x4 c = (f32x4){0.f, 0.f, 0.f, 0.f};
#pragma unroll
              for (int ks = 0; ks < 2; ++ks) c = __builtin_amdgcn_mfma_f32_16x16x32_bf16(LDF(VT, fJ[dd], ks), LDF(AM, fTi, ks), c, 0, 0, 0);
#pragma unroll
              for (int ks = 0; ks < 4; ++ks) c = __builtin_amdgcn_mfma_f32_16x16x32_bf16(LDF2(STBr, fJ[dd], ks), LDF2(QS, fTi, ks), c, 0, 0, 0);
              if (l0t >= NMETA && !(a.flags & 8)) *(u32x2*)(P + ((size_t)b * SEQ + (l0t - NMETA)) * LDP + C_GV + h * 256 + s * 64 + di * 16 + 4 * fq) = (u32x2){pk2(c[0], c[1]), pk2(c[2], c[3])}; } }
        { const f32x4 dec = *(const LAS f32x4*)(BL + wave * 16 + 4 * fq);
          bf16x8 af[2];
#pragma unroll
          for (int ks = 0; ks < 2; ++ks) af[ks] = LDF(KDT, fW, ks);
#pragma unroll
          for (int dt = 0; dt < 4; ++dt) { st[dt] = st[dt] * dec;
#pragma unroll
              for (int ks = 0; ks < 2; ++ks) st[dt] = __builtin_amdgcn_mfma_f32_16x16x32_bf16(af[ks], LDF(VT, mkfo(dt, fr, fX), ks), st[dt], 0, 0, 0);
              const int dk0 = wave * 16 + 4 * fq;
              *(LAS u32x2*)(STBw + (dk0 >> 6) * 4096 + swz(dt * 16 + fr, dk0 & 63)) = (u32x2){pk2(st[dt][0], st[dt][1]), pk2(st[dt][2], st[dt][3])}; } }
    }
    __syncthreads();
#undef GL_LOAD
#undef GL_BAR
}

__device__ __forceinline__ void phase_glanorm(const Args& a, const int w, const int nw) {
    const int tid_ = tidx(), wave = tid_ >> 6, lane = tid_ & 63;
    const bf16_t* P = (const bf16_t*)(a.ws + WS_P); bf16_t* A12 = (bf16_t*)(a.ws + WS_R5);
    float gn[8];
#pragma unroll
    for (int e = 0; e < 8; ++e) gn[e] = a.in[6][((8 * lane) & 255) + e];
    for (int row = w * 8 + wave; row < TR; row += nw * 8) {
        const bf16_t* pr = P + (size_t)row * LDP;
        u32x4 ov[2], rv[2];
#pragma unroll
        for (int j = 0; j < 2; ++j) { ov[j] = *(const u32x4*)(pr + C_GV + 8 * (lane + 64 * j)); rv[j] = *(const u32x4*)(pr + C_GR + 8 * (lane + 64 * j)); }
#pragma unroll
        for (int j = 0; j < 2; ++j) { float o[8], r[8]; float ss = 0.f;
#pragma unroll
            for (int q = 0; q < 4; ++q) { o[2 * q] = bf_lo(ov[j][q]); o[2 * q + 1] = bf_hi(ov[j][q]); r[2 * q] = bf_lo(rv[j][q]); r[2 * q + 1] = bf_hi(rv[j][q]); ss += o[2 * q] * o[2 * q] + o[2 * q + 1] * o[2 * q + 1]; }
            ss = red16(ss); ss += __shfl_xor(ss, 16);
            const float rstd = rsqrtf(ss * (1.0f / 256.0f) + EPS);
            float y[8];
#pragma unroll
            for (int e = 0; e < 8; ++e) y[e] = o[e] * rstd * gn[e] * (r[e] * sigmoidf_(r[e]));
            *(u32x4*)(A12 + (size_t)row * 2048 + 8 * (lane + 64 * j)) = (u32x4){pk2(y[0], y[1]), pk2(y[2], y[3]), pk2(y[4], y[5]), pk2(y[6], y[7])}; }
    }
}

__device__ __forceinline__ void phase_router(const Args& a, LAS unsigned char* lds) {
    const int tid = tidx(), wave = tid >> 6, lane = tid & 63, fr = lane & 15, fq = lane >> 4;
    constexpr int WPITCH = 2064;
    LAS int* HIST = (LAS int*)(lds + 64 * WPITCH);
    const float* gf = a.in[26]; const float* brt = a.in[28];
    const bf16_t* h2 = (const bf16_t*)(a.ws + WS_R5); bf16_t* U2 = (bf16_t*)(a.ws + WS_U2);
    int* tope = (int*)(a.ws + WS_TOPE); float* topc = (float*)(a.ws + WS_TOPC); int* cnt = (int*)(a.ws + WS_CNT);
    { const u32x4* src = (const u32x4*)(a.ws + WS_WRS);
      for (int i = tid; i < 64 * 128; i += 512) *(LAS u32x4*)(lds + (i >> 7) * WPITCH + (i & 127) * 16) = src[i]; }
    if (tid < 32) HIST[tid] = 0;
    __syncthreads();
    const int G = gridDim.x, RPB = (TR + G - 1) / G;
    const int r0 = blockIdx.x * RPB, r1 = (r0 + RPB < TR) ? (r0 + RPB) : TR;
    float bias[8];
#pragma unroll
    for (int j = 0; j < 8; ++j) bias[j] = brt[(j >> 2) * 16 + 4 * fq + (j & 3)];
    for (int rg = r0 + wave * 16; rg < r1; rg += 128) {
        const int row = rg + fr; const bool ok = row < r1;
        const u32x4* hp = (const u32x4*)(h2 + (size_t)(ok ? row : r0) * D) + fq;
        u32x4 hv[32];
#pragma unroll
        for (int s = 0; s < 32; ++s) hv[s] = hp[s * 4];
        float ss = 0.f;
#pragma unroll
        for (int s = 0; s < 32; ++s)
#pragma unroll
            for (int c = 0; c < 4; ++c) { const float lo = bf_lo(hv[s][c]), hi = bf_hi(hv[s][c]); ss += lo * lo; ss += hi * hi; }
        ss += __shfl_xor(ss, 16); ss += __shfl_xor(ss, 32);
        const float rs = rsqrtf(ss * (1.0f / D) + EPS);
#pragma unroll
        for (int s = 0; s < 32; ++s) asm volatile("" : "+v"(hv[s]));
        f32x4 acc0 = (f32x4){0.f, 0.f, 0.f, 0.f}, acc1 = acc0;
        const LAS unsigned char* wp = lds + fr * WPITCH + fq * 16;
#pragma unroll
        for (int s = 0; s < 32; ++s) {
            const bf16x8 tk = __builtin_bit_cast(bf16x8, hv[s]);
            const bf16x8 w0h = *(const LAS bf16x8*)(wp + s * 64), w1h = *(const LAS bf16x8*)(wp + 16 * WPITCH + s * 64);
            const bf16x8 w0l = *(const LAS bf16x8*)(wp + 32 * WPITCH + s * 64), w1l = *(const LAS bf16x8*)(wp + 48 * WPITCH + s * 64);
            acc0 = __builtin_amdgcn_mfma_f32_16x16x32_bf16(w0h, tk, acc0, 0, 0, 0); acc1 = __builtin_amdgcn_mfma_f32_16x16x32_bf16(w1h, tk, acc1, 0, 0, 0);
            acc0 = __builtin_amdgcn_mfma_f32_16x16x32_bf16(w0l, tk, acc0, 0, 0, 0); acc1 = __builtin_amdgcn_mfma_f32_16x16x32_bf16(w1l, tk, acc1, 0, 0, 0);
            if ((s & 3) == 3) asm volatile("" : "+v"(acc0), "+v"(acc1) :: "memory");
        }
#pragma unroll
        for (int s = 0; s < 32; ++s) asm volatile("" : "+v"(hv[s]));
        { u32x4* up = (u32x4*)(U2 + (size_t)row * D) + fq;
#pragma unroll
          for (int s = 0; s < 32; ++s) { u32x4 w;
#pragma unroll
              for (int c = 0; c < 4; ++c) w[c] = pk2(bf_lo(hv[s][c]) * rs, bf_hi(hv[s][c]) * rs);
              if (ok) up[s * 4] = w; } }
        float v[8];
#pragma unroll
        for (int j = 0; j < 4; ++j) { v[j] = acc0[j] * rs + bias[j]; v[4 + j] = acc1[j] * rs + bias[4 + j]; }
        int ti[4]; float tv[4];
#pragma unroll
        for (int kk = 0; kk < 4; ++kk) { float bv = v[0]; int be = 4 * fq;
#pragma unroll
            for (int j = 1; j < 8; ++j) { const int ej = (j >> 2) * 16 + 4 * fq + (j & 3); if (v[j] > bv) { bv = v[j]; be = ej; } }
#pragma unroll
            for (int o = 16; o < 64; o <<= 1) { const float ov = __shfl_xor(bv, o); const int oe = __shfl_xor(be, o); const bool g = (ov > bv) || (ov == bv && oe < be); bv = g ? ov : bv; be = g ? oe : be; }
            ti[kk] = be; tv[kk] = bv;
#pragma unroll
            for (int j = 0; j < 8; ++j) { const int ej = (j >> 2) * 16 + 4 * fq + (j & 3); v[j] = (ej == be) ? -3.0e38f : v[j]; } }
        if (fq == 0 && ok) {
            const float e1 = __expf(tv[1] - tv[0]), e2 = __expf(tv[2] - tv[0]), e3 = __expf(tv[3] - tv[0]); const float inv = 1.0f / (1.0f + e1 + e2 + e3);
            *(int4*)(tope + (size_t)row * 4) = make_int4(ti[0], ti[1], ti[2], ti[3]);
            *(float4*)(topc + (size_t)row * 4) = make_float4(inv, e1 * inv, e2 * inv, e3 * inv);
#pragma unroll
            for (int kk = 0; kk < 4; ++kk) __hip_atomic_fetch_add(HIST + ti[kk], 1, __ATOMIC_RELAXED, __HIP_MEMORY_SCOPE_WORKGROUP);
        }
    }
    __syncthreads();
    if (tid < 32) cnt[blockIdx.x * 32 + tid] = HIST[tid];
    __syncthreads();
    const int gw = blockIdx.x * 8 + wave, NGW = gridDim.x * 8;
    constexpr int J_GU = 16 * 64;
    for (int job = gw + a.ntail * J_GU; job < NE * J_GU; job += NGW) { const int e = job / J_GU, r = job % J_GU;
        tr_item<2>(a.in[29] + (size_t)e * 1024 * 2048, 2048, 1024, (bf16_t*)a.out + (size_t)e * 2048 * 1024, 1024, (r % 16) * 64, (r / 16) * 32, gf, lane); }
}

struct TrJob { const float* src; bf16_t* dst; const float* scale; int ld, k0, n0, gu; };
__device__ __forceinline__ void tr_job(const Args& a, int job, TrJob& J) {
    constexpr int J_GU = 16 * 64, J_DN = 16 * 32;
    if (job < NE * J_DN) { const int e = job / J_DN, r = job % J_DN; J.src = a.in[31] + (size_t)e * 1024 * 1024; J.ld = 1024; J.dst = (bf16_t*)(a.ws + WS_WDN) + (size_t)e * 1024 * 1024; J.k0 = (r % 16) * 64; J.n0 = (r / 16) * 32; J.scale = nullptr; J.gu = 0; }
    else { const int j2 = job - NE * J_DN, e = j2 / J_GU, r = j2 % J_GU; J.src = a.in[29] + (size_t)e * 1024 * 2048; J.ld = 2048; J.dst = (bf16_t*)a.out + (size_t)e * 2048 * 1024; J.k0 = (r % 16) * 64; J.n0 = (r / 16) * 32; J.scale = a.in[26]; J.gu = 1; }
}
__device__ __forceinline__ void tr_loadv(const TrJob& J, int lane, f32x4 (&v)[8]) {
    const int kr = lane >> 3, c4 = (lane & 7) * 4, n = J.n0 + c4, kb = J.k0 + 8 * kr;
    int sc = n; if (J.gu) { const int pn = n >> 8, r = n & 255, d = pn * 128 + (r & 127); sc = (r < 128) ? d : 1024 + d; }
#pragma unroll
    for (int i = 0; i < 8; ++i) v[i] = *(const f32x4*)(J.src + (size_t)(kb + i) * J.ld + sc);
}
__device__ __forceinline__ void tr_storev(const TrJob& J, int lane, f32x4 (&v)[8]) {
    const int kr = lane >> 3, c4 = (lane & 7) * 4, n = J.n0 + c4, kb = J.k0 + 8 * kr;
    if (J.scale) { const f32x4 s0 = *(const f32x4*)(J.scale + kb), s1 = *(const f32x4*)(J.scale + kb + 4);
#pragma unroll
        for (int i = 0; i < 4; ++i) { v[i] = v[i] * s0[i]; v[4 + i] = v[4 + i] * s1[i]; } }
#pragma unroll
    for (int j = 0; j < 4; ++j) {
        u32x4 o; o.x = pk2(v[0][j], v[1][j]); o.y = pk2(v[2][j], v[3][j]); o.z = pk2(v[4][j], v[5][j]); o.w = pk2(v[6][j], v[7][j]);
        __builtin_nontemporal_store(o, (u32x4*)(J.dst + (size_t)(n + j) * 1024 + kb)); }
}
__device__ __forceinline__ void convert_early(const Args& a, int cw, int ncw) {
    const int tid = tidx(), wave = tid >> 6, lane = tid & 63;
    const int gw = cw * 8 + wave, NGW = ncw * 8;
    constexpr int J_GU = 16 * 64, J_DN = 16 * 32;
    const int NJ = NE * J_DN + a.ntail * J_GU;
    TrJob ja, jb; f32x4 va[8], vb[8];
    int job = gw;
    if (job < NJ) { tr_job(a, job, ja); tr_loadv(ja, lane, va); }
    while (job < NJ) {
        if (job + NGW < NJ) { tr_job(a, job + NGW, jb); tr_loadv(jb, lane, vb); }
        tr_storev(ja, lane, va);
        job += NGW; if (job >= NJ) break;
        if (job + NGW < NJ) { tr_job(a, job + NGW, ja); tr_loadv(ja, lane, va); }
        tr_storev(jb, lane, vb);
        job += NGW;
    }
}

__device__ __forceinline__ void phase_positions(const Args& a, LAS unsigned char* lds) {
    const int tid = tidx();
    LAS int* PB = (LAS int*)lds;
    LAS int* PTt = PB + 512;
    LAS int* BASE = PTt + 512;
    LAS int* TOT = BASE + 32;
    LAS int* PST = TOT + 32;
    LAS int* ENT = PST + 64;
    LAS int* RNK = ENT + 8192;
    LAS int* WC = RNK + 8192;
    const int* cnt = (const int*)(a.ws + WS_CNT); const int* tope = (const int*)(a.ws + WS_TOPE); const float* topc = (const float*)(a.ws + WS_TOPC);
    int* pos = (int*)(a.ws + WS_POS); int* tok = (int*)(a.ws + WS_TOK); float* cw = (float*)(a.ws + WS_CW); int* misc = (int*)(a.ws + WS_MISC);
    const int G = gridDim.x, RPB = (TR + G - 1) / G;
    { const int e = tid & 31, part = tid >> 5; int sb = 0, st = 0;
      for (int bb = part; bb < G; bb += 16) { const int c = cnt[bb * 32 + e]; st += c; if (bb < (int)blockIdx.x) sb += c; }
      PB[part * 32 + e] = sb; PTt[part * 32 + e] = st; }
    __syncthreads();
    if (tid < 32) { int sb = 0, st = 0;
#pragma unroll
        for (int p = 0; p < 16; ++p) { sb += PB[p * 32 + tid]; st += PTt[p * 32 + tid]; }
        BASE[tid] = sb; TOT[tid] = st; }
    __syncthreads();
    if (tid == 0) { int acc = 0; for (int e = 0; e < 32; ++e) { PST[e] = acc * 256; acc += (TOT[e] + 255) >> 8; } PST[32] = acc * 256; }
    __syncthreads();
    const int r0 = blockIdx.x * RPB, r1 = (r0 + RPB < TR) ? (r0 + RPB) : TR;
    const int nent = (r1 > r0) ? (r1 - r0) * 4 : 0;
    for (int i = tid; i < nent; i += 512) ENT[i] = tope[(size_t)r0 * 4 + i];
    __syncthreads();
    const int nchunk = (nent + 63) >> 6;
    for (int c = tid >> 6; c < nchunk; c += 8) { const int lane = tid & 63, i = c * 64 + lane; const int e = (i < nent) ? ENT[i] : -1; int myrank = 0;
        for (int q = 0; q < 32; ++q) { const unsigned long long m = __ballot(e == q); if (e == q) myrank = __popcll(m & ((1ull << lane) - 1ull)); if (lane == q) WC[c * 32 + q] = __popcll(m); }
        if (i < nent) RNK[i] = myrank; }
    __syncthreads();
    if (tid < 32) { int acc = 0; for (int c = 0; c < nchunk; ++c) { const int t = WC[c * 32 + tid]; WC[c * 32 + tid] = acc; acc += t; } }
    __syncthreads();
    for (int i = tid; i < nent; i += 512) { const int e = ENT[i], p = PST[e] + BASE[e] + WC[(i >> 6) * 32 + e] + RNK[i]; pos[(size_t)r0 * 4 + i] = p; tok[p] = r0 + (i >> 2); cw[p] = topc[(size_t)r0 * 4 + i]; }
    for (int e = blockIdx.x; e < 32; e += G) for (int p = PST[e] + TOT[e] + tid; p < PST[e + 1]; p += 512) { tok[p] = 0; cw[p] = 0.f; }
    if (blockIdx.x == 0) { const int MT = PST[32] >> 8;
        for (int m = tid; m < MT; m += 512) { int e = 0;
            for (int q = 1; q < 32; ++q) e = (PST[q] <= m * 256) ? q : e;
            misc[1 + m] = e; }
        if (tid == 0) misc[0] = MT; }
}

__device__ __forceinline__ void phase_final(const Args& a) {
    const int tid_ = tidx(), wave = tid_ >> 6, lane = tid_ & 63;
    const bf16_t* h2 = (const bf16_t*)(a.ws + WS_R5); const unsigned char* YS = (const unsigned char*)(a.ws + WS_YS); const int* pos = (const int*)(a.ws + WS_POS);
    const float* gfin = a.in[33];
    f32x4 g4[4];
#pragma unroll
    for (int j = 0; j < 4; ++j) g4[j] = ((const f32x4*)gfin)[lane + 64 * j];
    for (int row = blockIdx.x * 8 + wave; row < TR; row += gridDim.x * 8) {
        const int4 pp = *(const int4*)(pos + (size_t)row * 4);
        const int ps[4] = {pp.x, pp.y, pp.z, pp.w};
        f32x4 v[4]; float ss = 0.f;
#pragma unroll
        for (int j = 0; j < 4; ++j) { const u32x2 hw = ((const u32x2*)(h2 + (size_t)row * D))[lane + 64 * j];
            f32x4 sy = (f32x4){0.f, 0.f, 0.f, 0.f};
#pragma unroll
            for (int k = 0; k < 4; ++k) { const unsigned w = ((const unsigned*)(YS + (size_t)ps[k] * D))[lane + 64 * j];
                const f32x2 lo = __builtin_amdgcn_cvt_pk_f32_fp8((int)w, false), hi = __builtin_amdgcn_cvt_pk_f32_fp8((int)w, true);
                sy.x += lo.x; sy.y += lo.y; sy.z += hi.x; sy.w += hi.y; }
            v[j] = (f32x4){bf_lo(hw.x), bf_hi(hw.x), bf_lo(hw.y), bf_hi(hw.y)} + sy * (1.0f / pg8::YS_SCALE);
            ss += (v[j].x * v[j].x + v[j].y * v[j].y) + (v[j].z * v[j].z + v[j].w * v[j].w); }
        const float rstd = rsqrtf(wave_sum(ss) * (1.0f / D) + EPS);
        f32x4* o = (f32x4*)(a.out + (size_t)row * D);
#pragma unroll
        for (int j = 0; j < 4; ++j) o[lane + 64 * j] = v[j] * rstd * g4[j];
    }
}

__global__ void __launch_bounds__(512, 2) fwd(Args args) {
    extern __shared__ __attribute__((aligned(16))) unsigned char smem[];
    LAS unsigned char* lds = (LAS unsigned char*)smem;
    const int lo = args.ph_lo, hi = args.ph_hi, G = gridDim.x;
    volatile LAS unsigned* MISC = (volatile LAS unsigned*)(lds + LDS_MISC);
    if (threadIdx.x < 4) MISC[threadIdx.x] = 0u;
    __syncthreads();
    XcdBarrier bar; bar.bar = (unsigned*)(args.ws + WS_BAR); bar.x = 0; bar.st = MISC;
    if (hi - lo > 1) bar = xcd_barrier_post((unsigned*)(args.ws + WS_BAR), MISC);
#define IN(k) (lo <= (k) && (k) < hi)
#define SEAM(k) do { if (IN(k) && IN((k) + 1)) xcd_barrier(bar); } while (0)
    unsigned char* ws = args.ws;
    const bool fuse4 = (G == 256);
    if (IN(0)) { phase_prologue(args, lds); } SEAM(0);
    if (IN(1)) {
        pg8::ProbDense S; S.A = (const bf16_t*)(ws + WS_XB); S.lda = D; S.Bt = (const bf16_t*)(ws + WS_WIN); S.ldb = 1024; S.so.init(TR / 256, LDP / 256, G, (int)blockIdx.x, MK_WGM_INPROJ);
        pg8::EpiBf16 E{(bf16_t*)(ws + WS_P), LDP};
        pg8::gemm_phase<pg8::EpiBf16, pg8::ProbDense, 1024>(lds, S, E);
    } SEAM(1);
    if (IN(2)) { phase_lora(args, lds); } SEAM(2);
    if (IN(3)) { for (int it = blockIdx.x; it < 256; it += G) { if (it < 128) { if (!(args.flags & 2)) rwkv_item(args, lds, it); } else { if (!(args.flags & 1)) gla_item(args, lds, it - 128); } __syncthreads(); }
                 if (fuse4 && (int)blockIdx.x >= G / 2) {
                     asm volatile("s_waitcnt vmcnt(0)" ::: "memory"); __syncthreads();
                     if (threadIdx.x == 0) { unsigned* c_ = (unsigned*)(ws + WS_BAR) + XB_GLA; const unsigned n_ = (unsigned)(G - G / 2); unsigned sp_ = 0u;
                         __builtin_amdgcn_fence(__ATOMIC_RELEASE, "agent"); asm volatile("s_waitcnt vmcnt(0)" ::: "memory"); (void)xb_add(c_, 1u);
                         while (xb_ld(c_) < n_) { __builtin_amdgcn_s_sleep(4); if (++sp_ > XB_SPIN_CAP) break; }
                         __builtin_amdgcn_fence(__ATOMIC_ACQUIRE, "agent"); asm volatile("s_waitcnt vmcnt(0)" ::: "memory"); }
                     __syncthreads();
                     phase_glanorm(args, (int)blockIdx.x - G / 2, G - G / 2); }
                 if ((int)blockIdx.x >= G / 2 && !(args.flags & 16)) convert_early(args, (int)blockIdx.x - G / 2, G - G / 2); } SEAM(3);
    if (IN(4)) { if (!fuse4) phase_glanorm(args, (int)blockIdx.x, G); } if (!fuse4) SEAM(4);
    if (IN(5)) {
        pg8::ProbMix S; S.A = (const bf16_t*)(ws + WS_R5); S.Bt = (const bf16_t*)(ws + WS_WGR); S.so.init(TR / 256, 4, G, (int)blockIdx.x);
        pg8::EpiMix E{(const bf16_t*)(ws + WS_P), (bf16_t*)(ws + WS_MIX)};
        pg8::gemm_phase<pg8::EpiMix, pg8::ProbMix, 1024>(lds, S, E);
    } SEAM(5);
    if (IN(6)) {
        pg8::ProbDense S; S.A = (const bf16_t*)(ws + WS_MIX); S.lda = D; S.Bt = (const bf16_t*)(ws + WS_WOUT); S.ldb = 1024; S.so.init(TR / 256, 4, G, (int)blockIdx.x);
        pg8::EpiH2 E{args.in[0], (bf16_t*)(ws + WS_R5)};
        pg8::gemm_phase<pg8::EpiH2, pg8::ProbDense, 1024>(lds, S, E);
    } SEAM(6);
    if (IN(7)) { phase_router(args, lds); } SEAM(7);
    if (IN(8)) { phase_positions(args, lds); } SEAM(8);
    if (IN(9)) {
        const int* misc = (const int*)(ws + WS_MISC); const int MT = __builtin_amdgcn_readfirstlane(misc[0]);
        pg8::ProbMoE S; S.A = (const bf16_t*)(ws + WS_U2); S.tok = (const int*)(ws + WS_TOK); S.Bt = (const bf16_t*)args.out; S.Bt2 = S.Bt; S.ntail = 0; S.nN = 8; S.tile2e = misc + 1; S.so.init(MT, 8, G, (int)blockIdx.x, MK_WGM_MOE);
        S.rdy = nullptr; S.need = 0u; S.mask = 0u;
        pg8::EpiSwiglu E{args.in[30], (bf16_t*)(ws + WS_ACT), (unsigned*)(ws + WS_BAR) + XB_RDY};
        pg8::gemm_phase<pg8::EpiSwiglu, pg8::ProbMoE, 1024>(lds, S, E);
    }
    __syncthreads();
    if (IN(10)) {
        const int* misc = (const int*)(ws + WS_MISC); const int MT = __builtin_amdgcn_readfirstlane(misc[0]);
        const int cs = (((int)blockIdx.x - (MT * 8) % G) % G + G) % G;
        pg8::ProbMoE S; S.A = (const bf16_t*)(ws + WS_ACT); S.tok = nullptr; S.Bt = (const bf16_t*)(ws + WS_WDN); S.Bt2 = S.Bt; S.ntail = 0; S.nN = 4; S.tile2e = misc + 1; S.so.init(MT, 4, G, cs, MK_WGM_MOE);
        S.rdy = (unsigned*)(ws + WS_BAR) + XB_RDY; S.need = 64u;
        {
            const int t_ = tidx();
            if (t_ < 64) { pg8::Unit u_; unsigned ok = 1u;
                if (t_ < 32 && S.so.next(t_, u_)) ok = (xb_ld(S.rdy + u_.pm) >= S.need) ? 1u : 0u;
                const unsigned long long bal = __ballot(ok != 0u);
                __builtin_amdgcn_fence(__ATOMIC_ACQUIRE, "agent");
                asm volatile("s_waitcnt vmcnt(0)" ::: "memory");
                if (t_ == 0) MISC[16] = (unsigned)bal; }
            __syncthreads();
            S.mask = (unsigned)__builtin_amdgcn_readfirstlane((int)MISC[16]); }
        pg8::EpiDown E{args.in[32], (const float*)(ws + WS_CW), (unsigned char*)(ws + WS_YS)};
        pg8::gemm_phase<pg8::EpiDown, pg8::ProbMoE, 1024>(lds, S, E);
    } SEAM(10);
    if (IN(11)) { phase_final(args); }
#undef IN
#undef SEAM
}
}

extern "C" void kernel_launch(void* const* d_in, const int* in_sizes, int n_in, void* d_out, int out_size, void* d_ws, size_t ws_size, hipStream_t stream) {
    static int grid = 0;
    if (grid == 0) {
        if (n_in != 34 || ws_size < mk::WS_END) { fprintf(stderr, "kernel_launch: expected 34 inputs and >= %zu bytes of workspace (got %d, %zu)\n", (size_t)mk::WS_END, n_in, ws_size); grid = -1; return; }
        int dev = 0, cus = 0;
        if (hipGetDevice(&dev) != hipSuccess || hipDeviceGetAttribute(&cus, hipDeviceAttributeMultiprocessorCount, dev) != hipSuccess) { grid = -1; return; }
        if (hipFuncSetAttribute((const void*)mk::fwd, hipFuncAttributeMaxDynamicSharedMemorySize, mk::LDS_BYTES) != hipSuccess) { fprintf(stderr, "kernel_launch: hipFuncSetAttribute failed\n"); grid = -1; return; }
        int per_cu = 0;
        if (hipOccupancyMaxActiveBlocksPerMultiprocessor(&per_cu, (const void*)mk::fwd, 512, mk::LDS_BYTES) != hipSuccess || per_cu < 1) { fprintf(stderr, "kernel_launch: occupancy query says %d blocks per CU\n", per_cu); }
        (void)hipGetLastError();
        grid = cus > 0 ? cus : 256;
    }
    if (grid < 0) return;
    (void)hipMemsetAsync((char*)d_ws + mk::WS_BAR, 0, 16384, stream);
    mk::Args a{};
    for (int i = 0; i < 34; ++i) a.in[i] = (const float*)d_in[i];
    a.out = (float*)d_out; a.ws = (unsigned char*)d_ws;
    a.ntail = 32;
#if MK_SPLIT
    for (int ph = 0; ph < mk::NPHASE; ++ph) { a.ph_lo = ph; a.ph_hi = ph + 1; a.flags = 0; hipLaunchKernelGGL(mk::fwd, dim3(grid), dim3(512), mk::LDS_BYTES, stream, a);
#ifdef MK_REP
        if (ph == MK_REP) { a.flags = MK_REP_FLAGS; for (int r = 0; r < MK_REP_N; ++r) hipLaunchKernelGGL(mk::fwd, dim3(grid), dim3(512), mk::LDS_BYTES, stream, a); }
#endif
    }
#else
    a.ph_lo = 0; a.ph_hi = mk::NPHASE;
    hipLaunchKernelGGL(mk::fwd, dim3(grid), dim3(512), mk::LDS_BYTES, stream, a);
#endif
}
```
